# Optimizing an MI355X kernel written in HIP

```python
import math
import jax, jax.numpy as jnp
from jax import lax
import numpy as np

D_MODEL = 2048
BATCH = 4
SEQ = 8192
DEPTH = 1

CTX_LEN = 256
GRID_W = 64

ATTN_HEADS = 8
ATTN_HEAD_DIM = 64
ATTN_VALUE_DIM = 2 * ATTN_HEAD_DIM
ATTN_WIDTH = ATTN_HEADS * ATTN_VALUE_DIM
QK_WIDTH = 2 * ATTN_HEADS * ATTN_HEAD_DIM
ROPE_THETA = 10000.0
Q_BLOCK = 128

POOL_WINDOWS = (2, 4, 8, 16)
POOL_GROUPS = len(POOL_WINDOWS)
POOL_WIDTH = D_MODEL // 2
POOL_GROUP_DIM = POOL_WIDTH // POOL_GROUPS

N_BRANCHES = 2
D_FF = 4 * D_MODEL
EPS = 1e-6

Q_OFF = 0
K_OFF = Q_OFF + QK_WIDTH
V_OFF = K_OFF + QK_WIDTH
P_OFF = V_OFF + ATTN_WIDTH
G_OFF = P_OFF + POOL_WIDTH
IN_WIDTH = G_OFF + N_BRANCHES * D_MODEL

kernel_name = "hybrid_diffattn_pool_dit_layer"


def rmsnorm(x, w):
    xf = x.astype(jnp.float32)
    y = xf * lax.rsqrt(jnp.mean(xf * xf, axis=-1, keepdims=True) + EPS)
    return (y * w.astype(jnp.float32)).astype(x.dtype)


def modulate(x, w, shift, scale):
    return rmsnorm(x, w) * (1 + scale) + shift


def split_qk(t):
    B, L, _ = t.shape
    return t.reshape(B, L, 2 * ATTN_HEADS, ATTN_HEAD_DIM).transpose(0, 2, 1, 3)


def split_v(t):
    B, L, _ = t.shape
    return t.reshape(B, L, ATTN_HEADS, ATTN_VALUE_DIM).transpose(0, 2, 1, 3)


def axial_rope(x, row, col):
    half = x.shape[-1] // 2
    inv_freq = ROPE_THETA ** (-jnp.arange(0, half, 2, dtype=jnp.float32) / half)

    def rot(xa, pos):
        ang = pos.astype(jnp.float32)[:, None] * inv_freq[None, :]
        cos, sin = jnp.cos(ang), jnp.sin(ang)
        x1, x2 = xa[..., : half // 2], xa[..., half // 2:]
        return jnp.concatenate([x1 * cos - x2 * sin, x1 * sin + x2 * cos], axis=-1)

    xf = x.astype(jnp.float32)
    out = jnp.concatenate([rot(xf[..., :half], row), rot(xf[..., half:], col)], axis=-1)
    return out.astype(x.dtype)


def diff_attention(q, k, v, lam):
    B, _, Lq, dh = q.shape
    Lk = k.shape[2]
    nblk = Lq // Q_BLOCK
    qb = q.reshape(B, 2 * ATTN_HEADS, nblk, Q_BLOCK, dh).transpose(2, 0, 1, 3, 4)
    scale = dh ** -0.5

    def block(qi):
        s = jnp.einsum('bhqd,bhkd->bhqk', qi, k, preferred_element_type=jnp.float32) * scale
        p = jax.nn.softmax(s, axis=-1).reshape(B, ATTN_HEADS, 2, Q_BLOCK, Lk)
        a = (p[:, :, 0] - lam * p[:, :, 1]).astype(v.dtype)
        return jnp.einsum('bhqk,bhkd->bqhd', a, v)

    o = lax.map(block, qb)
    return o.transpose(1, 0, 2, 3, 4).reshape(B, Lq, ATTN_HEADS, ATTN_VALUE_DIM)


def multiscale_pool(u, pool_w, pool_scale):
    B, L, _ = u.shape
    uf = u.astype(jnp.float32)
    cs = jnp.pad(jnp.cumsum(uf, axis=1), ((0, 0), (1, 0), (0, 0)))
    t = jnp.arange(L)
    outs = []
    for g, w in enumerate(POOL_WINDOWS):
        sl = slice(g * POOL_GROUP_DIM, (g + 1) * POOL_GROUP_DIM)
        lo = jnp.clip(t - w // 2, 0, L)
        hi = jnp.clip(t + w - w // 2, 0, L)
        csg = cs[..., sl]
        mean = (csg[:, hi] - csg[:, lo]) / (hi - lo).astype(jnp.float32)[None, :, None]
        outs.append(mean - uf[..., sl])
    d = jnp.stack(outs, axis=2).astype(u.dtype)
    y = jnp.einsum('blgc,gcd->blgd', d, pool_w).reshape(B, L, POOL_WIDTH)
    return y * pool_scale


def token_mixer(q, k_all, v_all, pool_in, gate_logits, lam, lam_init, subln_w,
                pool_w, pool_scale, w_a_up, w_b_up, w_o):
    B, L = pool_in.shape[:2]
    heads = diff_attention(q, k_all, v_all, lam)
    heads = rmsnorm(heads, subln_w) * (1.0 - lam_init)
    y_a = heads.reshape(B, L, ATTN_WIDTH) @ w_a_up
    y_b = multiscale_pool(pool_in, pool_w, pool_scale) @ w_b_up
    g = jax.nn.sigmoid(gate_logits.astype(jnp.float32)).astype(y_a.dtype)
    g_a, g_b = g[..., :D_MODEL], g[..., D_MODEL:]
    return (g_a * y_a + g_b * y_b) @ w_o


def sq_relu_mlp(h, w1, w2):
    return jnp.square(jax.nn.relu(h @ w1)) @ w2


def setup_inputs(seed: int = 0) -> dict:
    key = jax.random.key(seed)
    ks = jax.random.split(key, 24)
    f32 = jnp.float32

    def nrm(k, shape, scale):
        return jax.random.normal(k, shape, f32) * scale

    return {
        "x": nrm(ks[0], (BATCH, SEQ, D_MODEL), 1.0),
        "c": nrm(ks[1], (BATCH, D_MODEL), 1.0),
        "ctx": nrm(ks[2], (BATCH, CTX_LEN, D_MODEL), 1.0),
        "c_ctx": nrm(ks[3], (D_MODEL,), 1.0),
        "w_mod": nrm(ks[4], (DEPTH, D_MODEL, 6 * D_MODEL), D_MODEL ** -0.5),
        "b_mod": nrm(ks[5], (DEPTH, 6 * D_MODEL), 0.02),
        "norm_attn_w": 1.0 + nrm(ks[6], (DEPTH, D_MODEL), 0.1),
        "w_in": nrm(ks[7], (DEPTH, D_MODEL, IN_WIDTH), D_MODEL ** -0.5),
        "q_norm_w": 1.0 + nrm(ks[8], (DEPTH, ATTN_HEAD_DIM), 0.1),
        "k_norm_w": 1.0 + nrm(ks[9], (DEPTH, ATTN_HEAD_DIM), 0.1),
        "lambda_q1": nrm(ks[10], (DEPTH, ATTN_HEAD_DIM), 0.1),
        "lambda_k1": nrm(ks[11], (DEPTH, ATTN_HEAD_DIM), 0.1),
        "lambda_q2": nrm(ks[12], (DEPTH, ATTN_HEAD_DIM), 0.1),
        "lambda_k2": nrm(ks[13], (DEPTH, ATTN_HEAD_DIM), 0.1),
        "subln_w": 1.0 + nrm(ks[14], (DEPTH, ATTN_VALUE_DIM), 0.1),
        "pool_w": nrm(ks[15], (DEPTH, POOL_GROUPS, POOL_GROUP_DIM, POOL_GROUP_DIM), POOL_GROUP_DIM ** -0.5),
        "pool_scale": 1.0 + nrm(ks[16], (DEPTH, POOL_WIDTH), 0.1),
        "w_a_up": nrm(ks[17], (DEPTH, ATTN_WIDTH, D_MODEL), ATTN_WIDTH ** -0.5),
        "w_b_up": nrm(ks[18], (DEPTH, POOL_WIDTH, D_MODEL), POOL_WIDTH ** -0.5),
        "w_o": nrm(ks[19], (DEPTH, D_MODEL, D_MODEL), D_MODEL ** -0.5),
        "norm_mlp_w": 1.0 + nrm(ks[20], (DEPTH, D_MODEL), 0.1),
        "w_ff1": nrm(ks[21], (DEPTH, D_MODEL, D_FF), D_MODEL ** -0.5),
        "w_ff2": nrm(ks[22], (DEPTH, D_FF, D_MODEL), D_FF ** -0.5),
    }


def reference(x, c, ctx, c_ctx, w_mod, b_mod, norm_attn_w, w_in, q_norm_w, k_norm_w,
              lambda_q1, lambda_k1, lambda_q2, lambda_k2, subln_w, pool_w, pool_scale,
              w_a_up, w_b_up, w_o, norm_mlp_w, w_ff1, w_ff2):
    L = x.shape[1]
    rows = L // GRID_W
    row = jnp.repeat(jnp.arange(rows), GRID_W)
    col = jnp.tile(jnp.arange(GRID_W), rows)

    x_ctx = ctx
    for l in range(DEPTH):
        last = l == DEPTH - 1
        lam_init = 0.8 - 0.6 * math.exp(-0.3 * l)
        lam = (jnp.exp(jnp.sum(lambda_q1[l].astype(jnp.float32) * lambda_k1[l].astype(jnp.float32)))
               - jnp.exp(jnp.sum(lambda_q2[l].astype(jnp.float32) * lambda_k2[l].astype(jnp.float32)))
               + lam_init)

        mod = (jax.nn.silu(c) @ w_mod[l] + b_mod[l])[:, None, :]
        sa, ca, ga, sm, cm, gm = jnp.split(mod, 6, axis=-1)
        mod_c = jax.nn.silu(c_ctx) @ w_mod[l] + b_mod[l]
        sa_c, ca_c, ga_c, sm_c, cm_c, gm_c = jnp.split(mod_c, 6, axis=-1)

        h_c = modulate(x_ctx, norm_attn_w[l], sa_c, ca_c)
        if last:
            p_c_kv = h_c @ w_in[l][:, K_OFF:P_OFF]
        else:
            p_c = h_c @ w_in[l]
            p_c_kv = p_c[..., K_OFF:P_OFF]
        k_c = rmsnorm(split_qk(p_c_kv[..., :QK_WIDTH]), k_norm_w[l])
        v_c = split_v(p_c_kv[..., QK_WIDTH:])

        h = modulate(x, norm_attn_w[l], sa, ca)
        p = h @ w_in[l]
        q = axial_rope(rmsnorm(split_qk(p[..., Q_OFF:K_OFF]), q_norm_w[l]), row, col)
        k = axial_rope(rmsnorm(split_qk(p[..., K_OFF:V_OFF]), k_norm_w[l]), row, col)
        v = split_v(p[..., V_OFF:P_OFF])
        k_all = jnp.concatenate([k, k_c], axis=2)
        v_all = jnp.concatenate([v, v_c], axis=2)
        mix = token_mixer(q, k_all, v_all, p[..., P_OFF:G_OFF], p[..., G_OFF:], lam, lam_init,
                          subln_w[l], pool_w[l], pool_scale[l], w_a_up[l], w_b_up[l], w_o[l])
        x = x + ga * mix
        x = x + gm * sq_relu_mlp(modulate(x, norm_mlp_w[l], sm, cm), w_ff1[l], w_ff2[l])

        if not last:
            q_c = rmsnorm(split_qk(p_c[..., Q_OFF:K_OFF]), q_norm_w[l])
            mix_c = token_mixer(q_c, k_c, v_c, p_c[..., P_OFF:G_OFF], p_c[..., G_OFF:], lam, lam_init,
                                subln_w[l], pool_w[l], pool_scale[l], w_a_up[l], w_b_up[l], w_o[l])
            x_ctx = x_ctx + ga_c * mix_c
            x_ctx = x_ctx + gm_c * sq_relu_mlp(modulate(x_ctx, norm_mlp_w[l], sm_c, cm_c),
                                               w_ff1[l], w_ff2[l])
    return x
```

```cpp
#include <hip/hip_runtime.h>
#include <hip/hip_cooperative_groups.h>
#include <cstdio>
#include <cstdint>
namespace cg = cooperative_groups;

#ifndef MK_REP_MASK
#define MK_REP_MASK 0
#endif
#ifndef MK_MULTI
#define MK_MULTI 0
#endif

#define LAS __attribute__((address_space(3)))
typedef unsigned short bf16_t;
typedef short bf16x8 __attribute__((ext_vector_type(8)));
typedef short s16x4 __attribute__((ext_vector_type(4)));
typedef float f32x4 __attribute__((ext_vector_type(4)));
typedef float f32x16 __attribute__((ext_vector_type(16)));
typedef unsigned u32x4 __attribute__((ext_vector_type(4)));
typedef unsigned u32x2 __attribute__((ext_vector_type(2)));

constexpr int DM = 2048, NB = 4, SEQ = 8192, CTX = 256, MTOK = NB * SEQ, SKV = SEQ + CTX, MKV = NB * SKV;
constexpr int INW = 8192, DFF = 8192, NMOD = 6 * DM;
constexpr int LDQKV = 3072, LDPG = 5120;
constexpr float EPS = 1e-6f;
constexpr int NPHASE = 10;

constexpr size_t MiB = 1u << 20;
constexpr size_t WS_MOD = 0, WS_ROPE = 256 * 1024, WS_BAR = 512 * 1024;
constexpr size_t WS_WIN = 1 * MiB, WS_WFF1 = 33 * MiB, WS_WFF2 = 65 * MiB, WS_WO = 97 * MiB, WS_WA = 105 * MiB, WS_WB = 109 * MiB, WS_WP = 113 * MiB;
constexpr size_t WS_H = 114 * MiB, WS_HC = 242 * MiB, WS_QKV = 246 * MiB, WS_PG = 444 * MiB, WS_D = 764 * MiB, WS_POOLED = 828 * MiB, WS_OSUB = 892 * MiB;
constexpr size_t WS_HEADS = WS_OSUB + 64 * MiB, WS_X1 = WS_D  , WS_M = WS_H, WS_H2 = WS_OSUB, WS_U = WS_QKV, WS_END = 1020 * MiB;
static_assert(WS_QKV + (size_t)MKV * LDQKV * 2 <= WS_PG && WS_PG + (size_t)MTOK * LDPG * 2 <= WS_D && WS_U + (size_t)MTOK * DFF * 2 <= WS_D, "ws map");

__device__ __forceinline__ unsigned cvt_pk_bf16(float lo, float hi) { unsigned r; asm volatile("v_cvt_pk_bf16_f32 %0, %1, %2" : "=v"(r) : "v"(lo), "v"(hi)); return r; }
__device__ __forceinline__ float bflo(unsigned w) { return __uint_as_float(w << 16); }
__device__ __forceinline__ float bfhi(unsigned w) { return __uint_as_float(w & 0xffff0000u); }
__device__ __forceinline__ float wave_sum(float v) {
#pragma unroll
    for (int o = 1; o < 64; o <<= 1) v += __shfl_xor(v, o);
    return v;
}
__device__ __forceinline__ float sigmoidf_(float v) { return __builtin_amdgcn_rcpf(1.0f + __builtin_amdgcn_exp2f(-1.4426950408889634f * v)); }

__device__ __forceinline__ int lane_id_opaque() { unsigned m = ~0u; asm volatile("" : "+s"(m)); return (int)__builtin_amdgcn_mbcnt_hi(m, __builtin_amdgcn_mbcnt_lo(m, 0u)); }

namespace pg8 {
constexpr int BM = 256, BK = 64, HALF = 128, HTB = HALF * BK * 2, STAGE_BYTES = 8 * HTB, NXCD = 8, WGM = 8;
__host__ __device__ __forceinline__ int lds_byte(int r, int c) { const int st = (r >> 4) * 2 + (c >> 5), rr = r & 15, cc = c & 31, ob = rr * 64 + cc * 2; return st * 1024 + (ob ^ (((ob >> 9) & 1) << 5)); }
__host__ __device__ __forceinline__ void stage_rc(int b, int& R, int& C) { const int st = b / 1024, sb = b % 1024, swz = sb ^ (((sb >> 9) & 1) << 5); R = (st >> 1) * 16 + swz / 64; C = (st & 1) * 32 + (swz % 64) / 2; }
__host__ __device__ __forceinline__ int perm32(int rho) { const int n = rho >> 4, i = rho & 15; return 8 * (i >> 2) + 4 * n + (i & 3); }

struct Unit { int pm, pn; };
struct Gemm { const bf16_t* A; const bf16_t* Bt; int M, N, K, lda, ldb, akoff; size_t ksa, ksb; };

struct StaticOrder {
    int nM, nN, nwg, G, c;
    __device__ void init(int M, int N, int G_, int c_) { nM = M / BM; nN = N / BM; nwg = nM * nN; G = G_; c = c_; }
    __device__ bool next(int i, Unit& u) const {
        const long L = (long)i * G + c; if (L >= nwg) return false;
        int wgid = (int)L; { const int q = nwg / NXCD, r = nwg % NXCD, xcd = wgid % NXCD, off = wgid / NXCD; wgid = (xcd < r ? xcd * (q + 1) : r * (q + 1) + (xcd - r) * q) + off; }
        const int nig = WGM * nN, gid = wgid / nig, fm = gid * WGM, gsz = (nM - fm) < WGM ? (nM - fm) : WGM;
        u.pm = fm + ((wgid % nig) % gsz); u.pn = (wgid % nig) / gsz; return true;
    }
};

enum { E_G1 = 0, E_CTX, E_POOL, E_YA, E_YB, E_WO, E_FF1, E_FF2 };
template <int MODE> struct Epi {
    bf16_t* o16; bf16_t* o16b; float* o32; const float* x32; const float* vec; const bf16_t* g16;
    static __device__ __forceinline__ u32x4 pack8(const f32x4& v0, const f32x4& v1) { u32x4 w; w.x = cvt_pk_bf16(v0[0], v0[1]); w.y = cvt_pk_bf16(v0[2], v0[3]); w.z = cvt_pk_bf16(v1[0], v1[1]); w.w = cvt_pk_bf16(v1[2], v1[3]); return w; }
    static __device__ __forceinline__ void mul8(f32x4& v0, f32x4& v1, const u32x4& g) { v0[0] *= bflo(g.x); v0[1] *= bfhi(g.x); v0[2] *= bflo(g.y); v0[3] *= bfhi(g.y); v1[0] *= bflo(g.z); v1[1] *= bfhi(g.z); v1[2] *= bflo(g.w); v1[3] *= bfhi(g.w); }
    static __device__ __forceinline__ void add8(f32x4& v0, f32x4& v1, const u32x4& a) { v0[0] += bflo(a.x); v0[1] += bfhi(a.x); v0[2] += bflo(a.y); v0[3] += bfhi(a.y); v1[0] += bflo(a.z); v1[1] += bfhi(a.z); v1[2] += bflo(a.w); v1[3] += bfhi(a.w); }
    __device__ __forceinline__ void operator()(const f32x4 (&acc)[2][2][4][2], const Unit& u, int wr, int wc, int fr, int fq) const {
        const int rowt = u.pm * BM + wr * 64 + fr, colt = u.pn * BM + wc * 32 + 8 * fq;
        if constexpr (MODE == E_WO || MODE == E_FF2) {
            const float* gv = vec + (size_t)(rowt >> 13) * NMOD + colt;
            f32x4 g[2][2];
#pragma unroll
            for (int bj = 0; bj < 2; ++bj) { g[bj][0] = *(const f32x4*)(gv + bj * HALF); g[bj][1] = *(const f32x4*)(gv + bj * HALF + 4); }
#pragma unroll
            for (int ai = 0; ai < 2; ++ai) {
                if constexpr (MODE == E_WO) {
                    f32x4 xb[4][2][2];
#pragma unroll
                    for (int m = 0; m < 4; ++m)
#pragma unroll
                        for (int bj = 0; bj < 2; ++bj) { const size_t off = (size_t)(rowt + ai * HALF + m * 16) * DM + colt + bj * HALF;
                            xb[m][bj][0] = __builtin_nontemporal_load((const f32x4*)(x32 + off)); xb[m][bj][1] = __builtin_nontemporal_load((const f32x4*)(x32 + off + 4)); }
#pragma unroll
                    for (int m = 0; m < 4; ++m)
#pragma unroll
                        for (int bj = 0; bj < 2; ++bj) { const size_t off = (size_t)(rowt + ai * HALF + m * 16) * DM + colt + bj * HALF;
                            *(u32x4*)(o16 + off) = pack8(xb[m][bj][0] + g[bj][0] * acc[ai][bj][m][0], xb[m][bj][1] + g[bj][1] * acc[ai][bj][m][1]); }
                } else {
                    u32x4 xb[4][2];
#pragma unroll
                    for (int m = 0; m < 4; ++m)
#pragma unroll
                        for (int bj = 0; bj < 2; ++bj) xb[m][bj] = *(const u32x4*)(g16 + (size_t)(rowt + ai * HALF + m * 16) * DM + colt + bj * HALF);
#pragma unroll
                    for (int m = 0; m < 4; ++m)
#pragma unroll
                        for (int bj = 0; bj < 2; ++bj) { const size_t off = (size_t)(rowt + ai * HALF + m * 16) * DM + colt + bj * HALF;
                            f32x4 v0 = g[bj][0] * acc[ai][bj][m][0], v1 = g[bj][1] * acc[ai][bj][m][1];
                            add8(v0, v1, xb[m][bj]);
                            *(f32x4*)(o32 + off) = v0; *(f32x4*)(o32 + off + 4) = v1; }
                }
            }
        } else if constexpr (MODE == E_YA || MODE == E_YB) {
#pragma unroll
            for (int ai = 0; ai < 2; ++ai) {
                u32x4 gb[4][2], mb[4][2];
#pragma unroll
                for (int m = 0; m < 4; ++m)
#pragma unroll
                    for (int bj = 0; bj < 2; ++bj) { const int row = rowt + ai * HALF + m * 16, col = colt + bj * HALF;
                        gb[m][bj] = *(const u32x4*)(g16 + (size_t)row * LDPG + 1024 + (MODE == E_YB ? DM : 0) + col);
                        if constexpr (MODE == E_YB) mb[m][bj] = *(const u32x4*)(o16 + (size_t)row * DM + col); }
#pragma unroll
                for (int m = 0; m < 4; ++m)
#pragma unroll
                    for (int bj = 0; bj < 2; ++bj) { const int row = rowt + ai * HALF + m * 16, col = colt + bj * HALF;
                        f32x4 v0 = acc[ai][bj][m][0], v1 = acc[ai][bj][m][1];
                        mul8(v0, v1, gb[m][bj]);
                        if constexpr (MODE == E_YB) add8(v0, v1, mb[m][bj]);
                        *(u32x4*)(o16 + (size_t)row * DM + col) = pack8(v0, v1); }
            }
        } else {
#pragma unroll
        for (int ai = 0; ai < 2; ++ai)
#pragma unroll
            for (int m = 0; m < 4; ++m) {
                const int row = rowt + ai * HALF + m * 16;
#pragma unroll
                for (int bj = 0; bj < 2; ++bj) {
                    const int col = colt + bj * HALF;
                    f32x4 v0 = acc[ai][bj][m][0], v1 = acc[ai][bj][m][1];
                    if constexpr (MODE == E_G1) {
                        bf16_t* p;
                        if (u.pn < 12) { p = o16 + (size_t)(row + (row >> 13) * CTX) * LDQKV + col; }
                        else { p = o16b + (size_t)row * LDPG + (col - 3072);
                            if (u.pn >= 16) {
#pragma unroll
                                for (int j = 0; j < 4; ++j) { v0[j] = sigmoidf_(v0[j]); v1[j] = sigmoidf_(v1[j]); } } }
                        *(u32x4*)p = pack8(v0, v1);
                    } else if constexpr (MODE == E_CTX) {
                        *(u32x4*)(o16 + (size_t)(u.pm * SKV + SEQ + (row - u.pm * BM)) * LDQKV + 1024 + col) = pack8(v0, v1);
                    } else if constexpr (MODE == E_POOL) {
                        const f32x4 s0 = *(const f32x4*)(vec + col), s1 = *(const f32x4*)(vec + col + 4);
                        v0 = v0 * s0; v1 = v1 * s1;
                        *(u32x4*)(o16 + (size_t)row * 1024 + col) = pack8(v0, v1);
                    } else if constexpr (MODE == E_FF1) {
#pragma unroll
                        for (int j = 0; j < 4; ++j) { const float a = fmaxf(v0[j], 0.f), b = fmaxf(v1[j], 0.f); v0[j] = a * a; v1[j] = b * b; }
                        __builtin_nontemporal_store(pack8(v0, v1), (u32x4*)(o16 + (size_t)(col >> 6) * ((size_t)MTOK * 64) + (size_t)row * 64 + (col & 63)));
                    }
                }
            }
        }
    }
};

template <class EpiT>
__device__ __forceinline__ void gemm_phase(const int tid, LAS unsigned char* lds, const Gemm g, const StaticOrder& S, const EpiT& E) {
    const int wid = __builtin_amdgcn_readfirstlane(tid >> 6), lane = tid & 63, wr = wid >> 2, wc = wid & 3, fr = lane & 15, fq = lane >> 4;
    const int K = g.K, nt = K / BK;
    unsigned voffA[2], voffB[2];
#pragma unroll
    for (int i = 0; i < 2; ++i) { int R, C; stage_rc(tid * 16 + i * 8192, R, C); const int Rb = (R & ~31) + perm32(R & 31);
        voffA[i] = (unsigned)(R * g.lda + C) * 2u; voffB[i] = (unsigned)(Rb * g.ldb + C) * 2u; }
    const size_t kstepA = g.ksa, kstepB = g.ksb;
    const size_t hstepA = (size_t)HALF * g.lda * 2, hstepB = (size_t)HALF * g.ldb * 2;
    const size_t tstepA = 2 * hstepA, tstepB = 2 * hstepB;
    const unsigned ldsw = (unsigned)wid * 1024u;
    const int aoff = lds_byte(wr * 64 + fr, fq * 8), boff = lds_byte(wc * 32 + fr, fq * 8);
#define PG8_SA(b, h) (((b) * 2 + (h)) * HTB)
#define PG8_SB(b, h) ((4 + (b) * 2 + (h)) * HTB)
#define PG8_STAGE(bufoff, gbase, voff) do { _Pragma("unroll") for (int _i = 0; _i < 2; ++_i) \
        __builtin_amdgcn_global_load_lds((const unsigned*)((const char*)(gbase) + (voff)[_i]), (LAS unsigned*)(lds + (bufoff) + ldsw + _i * 8192), 16, 0, 0); } while (0)
#define PG8_LDA(dst, b, h) do { _Pragma("unroll") for (int m = 0; m < 4; ++m) _Pragma("unroll") for (int k = 0; k < 2; ++k) dst[m][k] = *(const LAS bf16x8*)(lds + PG8_SA(b, h) + aoff + m * 2048 + k * 1024); } while (0)
#define PG8_LDB(dst, b, h) do { _Pragma("unroll") for (int n = 0; n < 2; ++n) _Pragma("unroll") for (int k = 0; k < 2; ++k) dst[n][k] = *(const LAS bf16x8*)(lds + PG8_SB(b, h) + boff + n * 2048 + k * 1024); } while (0)
#define PG8_MMA(ai, bj, At, Bt) do { __builtin_amdgcn_s_setprio(1); _Pragma("unroll") for (int m = 0; m < 4; ++m) _Pragma("unroll") for (int n = 0; n < 2; ++n) _Pragma("unroll") for (int k = 0; k < 2; ++k) \
        acc[ai][bj][m][n] = __builtin_amdgcn_mfma_f32_16x16x32_bf16(Bt[n][k], At[m][k], acc[ai][bj][m][n], 0, 0, 0); __builtin_amdgcn_s_setprio(0); } while (0)
#define PG8_WAIT_V(n) asm volatile("s_waitcnt vmcnt(" #n ")" ::: "memory")
#define PG8_WAIT_L(n) asm volatile("s_waitcnt lgkmcnt(" #n ")" ::: "memory")
#define PG8_BAR __builtin_amdgcn_s_barrier()
#define PG8_SCHED __builtin_amdgcn_sched_barrier(0)
    Unit cur, nxt; int ui = 0;
    if (!S.next(0, cur)) return;
    f32x4 acc[2][2][4][2];
#pragma unroll
    for (int a = 0; a < 2; ++a)
#pragma unroll
        for (int b = 0; b < 2; ++b)
#pragma unroll
            for (int m = 0; m < 4; ++m)
#pragma unroll
                for (int n = 0; n < 2; ++n) acc[a][b][m][n] = (f32x4){0.f, 0.f, 0.f, 0.f};
    bf16x8 At[4][2], B0[2][2], B1[2][2];
    const char* cA = (const char*)g.A + (size_t)cur.pm * tstepA + (size_t)cur.pn * g.akoff * 2; const char* cB = (const char*)g.Bt + (size_t)cur.pn * tstepB;
    PG8_STAGE(PG8_SB(0, 0), cB, voffB); PG8_STAGE(PG8_SB(0, 1), cB + hstepB, voffB); PG8_STAGE(PG8_SA(0, 0), cA, voffA); PG8_STAGE(PG8_SA(0, 1), cA + hstepA, voffA);
    if (wr == 1) PG8_BAR;
    PG8_WAIT_V(2); PG8_BAR;
    PG8_STAGE(PG8_SB(1, 0), cB + kstepB, voffB); PG8_STAGE(PG8_SA(1, 0), cA + kstepA, voffA); PG8_STAGE(PG8_SB(1, 1), cB + hstepB + kstepB, voffB);
    PG8_WAIT_V(6); PG8_BAR;
    for (;;) {
        const bool has_next = S.next(ui + 1, nxt);
        const char* nA = has_next ? (const char*)g.A + (size_t)nxt.pm * tstepA + (size_t)nxt.pn * g.akoff * 2 : cA; const char* nB = has_next ? (const char*)g.Bt + (size_t)nxt.pn * tstepB : cB;
        for (int t = 0; t < nt; t += 2) {
            const bool last = (t == nt - 2);
            const char* a1 = cA + (size_t)(t + 1) * kstepA;
            const char* a2 = last ? nA : cA + (size_t)(t + 2) * kstepA; const char* b2 = last ? nB : cB + (size_t)(t + 2) * kstepB;
            const char* a3 = a2 + kstepA; const char* b3 = b2 + kstepB;
            PG8_LDB(B0, 0, 0); PG8_LDB(B1, 0, 1); PG8_SCHED; PG8_LDA(At, 0, 0); PG8_STAGE(PG8_SA(1, 1), a1 + hstepA, voffA);
            PG8_WAIT_V(8); PG8_WAIT_L(0); PG8_BAR; PG8_MMA(0, 0, At, B0); PG8_MMA(0, 1, At, B1); PG8_BAR; PG8_SCHED;
            PG8_LDA(At, 0, 1); PG8_STAGE(PG8_SB(0, 0), b2, voffB); PG8_STAGE(PG8_SB(0, 1), b2 + hstepB, voffB); PG8_STAGE(PG8_SA(0, 0), a2, voffA);
            PG8_WAIT_V(8); PG8_WAIT_L(0); PG8_BAR; PG8_MMA(1, 0, At, B0); PG8_MMA(1, 1, At, B1); PG8_BAR; PG8_SCHED;
            PG8_LDB(B0, 1, 0); PG8_LDB(B1, 1, 1); PG8_SCHED; PG8_LDA(At, 1, 0); PG8_STAGE(PG8_SA(0, 1), a2 + hstepA, voffA);
            PG8_WAIT_V(8); PG8_WAIT_L(0); PG8_BAR; PG8_MMA(0, 0, At, B0); PG8_MMA(0, 1, At, B1); PG8_BAR; PG8_SCHED;
            PG8_LDA(At, 1, 1); PG8_STAGE(PG8_SB(1, 0), b3, voffB); PG8_STAGE(PG8_SB(1, 1), b3 + hstepB, voffB); PG8_STAGE(PG8_SA(1, 0), a3, voffA);
            PG8_WAIT_V(8); PG8_WAIT_L(0); PG8_BAR; PG8_MMA(1, 0, At, B0); PG8_MMA(1, 1, At, B1); PG8_BAR; PG8_SCHED;
        }
        if (wr == 0) PG8_BAR;
        E(acc, cur, wr, wc, fr, fq);
        if (!has_next) break;
#pragma unroll
        for (int a = 0; a < 2; ++a)
#pragma unroll
            for (int b = 0; b < 2; ++b)
#pragma unroll
                for (int m = 0; m < 4; ++m)
#pragma unroll
                    for (int n = 0; n < 2; ++n) acc[a][b][m][n] = (f32x4){0.f, 0.f, 0.f, 0.f};
        cur = nxt; cA = nA; cB = nB; ++ui;
        if (wr == 1) PG8_BAR;
    }
    PG8_WAIT_V(0);
    PG8_BAR;
#undef PG8_SA
#undef PG8_SB
#undef PG8_STAGE
#undef PG8_LDA
#undef PG8_LDB
#undef PG8_MMA
#undef PG8_WAIT_V
#undef PG8_WAIT_L
#undef PG8_BAR
#undef PG8_SCHED
}
}

namespace att {
constexpr int NW = 8, QBLK = 32, KVBLK = 64;
constexpr float QSCALE = 0.125f * 1.4426950408889634f;
constexpr int SHM_V = KVBLK * 128 * 2, SHM_K = KVBLK * 64 * 2, NBUF = 4;
#define KSWZ64(row, colB) ((row) * 128 + ((colB) ^ ((((row) >> 1) & 7) << 4)))
#define SBAR() __builtin_amdgcn_sched_barrier(0)
__device__ __forceinline__ int crow(int r, int hi) { return (r & 3) + 8 * (r >> 2) + 4 * hi; }
#define PK4(P, BASE, OUT) do { unsigned a0 = cvt_pk_bf16(P[BASE + 0], P[BASE + 1]), a1 = cvt_pk_bf16(P[BASE + 2], P[BASE + 3]);   \
    unsigned b0 = cvt_pk_bf16(P[BASE + 4], P[BASE + 5]), b1 = cvt_pk_bf16(P[BASE + 6], P[BASE + 7]);                              \
    auto r0 = __builtin_amdgcn_permlane32_swap(a0, b0, false, false); auto r1 = __builtin_amdgcn_permlane32_swap(a1, b1, false, false); \
    u32x4 w = {r0[0], r1[0], r0[1], r1[1]}; OUT = *reinterpret_cast<bf16x8*>(&w); } while (0)
__device__ __forceinline__ void partialSM(f32x16& p0, float& l_reg, bf16x8& pa0, bf16x8& pa1) {
#pragma unroll
    for (int r = 0; r < 16; ++r) p0[r] = __builtin_amdgcn_exp2f(p0[r]);
    float ps = 0;
#pragma unroll
    for (int r = 0; r < 16; ++r) ps += p0[r];
    l_reg += ps;
    PK4(p0, 0, pa0); PK4(p0, 8, pa1);
}
__device__ __forceinline__ void finishSM(f32x16& p1, float& l_reg, bf16x8& pa2, bf16x8& pa3) {
#pragma unroll
    for (int r = 0; r < 16; ++r) p1[r] = __builtin_amdgcn_exp2f(p1[r]);
    float ps = 0;
#pragma unroll
    for (int r = 0; r < 16; ++r) ps += p1[r];
    l_reg += ps;
    PK4(p1, 0, pa2); PK4(p1, 8, pa3);
}
#undef PK4
__device__ __forceinline__ void qkt(f32x16& p0, f32x16& p1, const char* Ks, const bf16x8* qr, const f32x16& negm, int r32, int hi) {
#pragma unroll
    for (int d0 = 0; d0 < 4; ++d0) { const int cb = d0 * 32 + hi * 16;
        bf16x8 b0 = *reinterpret_cast<const bf16x8*>(Ks + KSWZ64(r32, cb));
        bf16x8 b1 = *reinterpret_cast<const bf16x8*>(Ks + KSWZ64(32 + r32, cb));
        if (d0 == 0) { p0 = __builtin_amdgcn_mfma_f32_32x32x16_bf16(b0, qr[0], negm, 0, 0, 0); p1 = __builtin_amdgcn_mfma_f32_32x32x16_bf16(b1, qr[0], negm, 0, 0, 0); }
        else { p0 = __builtin_amdgcn_mfma_f32_32x32x16_bf16(b0, qr[d0], p0, 0, 0, 0); p1 = __builtin_amdgcn_mfma_f32_32x32x16_bf16(b1, qr[d0], p1, 0, 0, 0); } }
}
__device__ __forceinline__ int v_st(int k, int c) { const int kk = (k & ~0xC) | ((k & 4) << 1) | ((k & 8) >> 1); return ((kk >> 3) * 4 + (c >> 5)) * 512 + ((kk & 7) * 32 + (c & 31)) * 2; }
__device__ __forceinline__ int v_rd_base(int lane) { return ((lane & 3) << 3) | (((lane >> 2) & 3) << 6) | (((lane >> 4) & 1) << 5) | (((lane >> 5) & 1) << 8); }
constexpr int v_rd_off(int d0, int ks, int half) { return d0 * 512 + ks * 4096 + half * 2048; }
template <int OFF> __device__ __forceinline__ s16x4 tr_read(int vb) {
    s16x4 r; asm volatile("ds_read_b64_tr_b16 %0, %1 offset:%2" : "=&v"(r) : "v"(vb), "i"(OFF) : "memory"); return r;
}
template <int D0> __device__ __forceinline__ void pv_one(f32x16& od, int vb, bf16x8 pa0, bf16x8 pa1, bf16x8 pa2, bf16x8 pa3) {
    const s16x4 l0 = tr_read<v_rd_off(D0, 0, 0)>(vb), h0 = tr_read<v_rd_off(D0, 0, 1)>(vb), l1 = tr_read<v_rd_off(D0, 1, 0)>(vb), h1 = tr_read<v_rd_off(D0, 1, 1)>(vb);
    const s16x4 l2 = tr_read<v_rd_off(D0, 2, 0)>(vb), h2 = tr_read<v_rd_off(D0, 2, 1)>(vb), l3 = tr_read<v_rd_off(D0, 3, 0)>(vb), h3 = tr_read<v_rd_off(D0, 3, 1)>(vb);
    asm volatile("s_waitcnt lgkmcnt(0)" ::: "memory"); SBAR();
#define PK(L, H) (bf16x8){L[0], L[1], L[2], L[3], H[0], H[1], H[2], H[3]}
    od = __builtin_amdgcn_mfma_f32_32x32x16_bf16(pa0, PK(l0, h0), od, 0, 0, 0);
    od = __builtin_amdgcn_mfma_f32_32x32x16_bf16(pa1, PK(l1, h1), od, 0, 0, 0);
    od = __builtin_amdgcn_mfma_f32_32x32x16_bf16(pa2, PK(l2, h2), od, 0, 0, 0);
    od = __builtin_amdgcn_mfma_f32_32x32x16_bf16(pa3, PK(l3, h3), od, 0, 0, 0);
#undef PK
}
__device__ __forceinline__ void pv_d0(f32x16* o, int vb, bf16x8 pa0, bf16x8 pa1, bf16x8 pa2, bf16x8 pa3) {
    pv_one<0>(o[0], vb, pa0, pa1, pa2, pa3); pv_one<1>(o[1], vb, pa0, pa1, pa2, pa3); pv_one<2>(o[2], vb, pa0, pa1, pa2, pa3); pv_one<3>(o[3], vb, pa0, pa1, pa2, pa3);
}
#define PKF(L, H) (bf16x8){L[0], L[1], L[2], L[3], H[0], H[1], H[2], H[3]}
template <int I, bool EXPS> __device__ __forceinline__ void pv_roll_step(f32x16* o, int vb, const bf16x8& pa0, const bf16x8& pa1, const bf16x8& pa2, const bf16x8& pa3, s16x4 (&L)[4], s16x4 (&H)[4], f32x16& c0, float& ps, unsigned (&cv)[4], bf16x8& ca0) {
    constexpr int ks = I >> 2, d0 = I & 3, sl = I & 3, rem = 15 - I, n = 2 * (rem < 3 ? rem : 3);
    asm volatile("s_waitcnt lgkmcnt(%0)" :: "n"(n) : "memory"); SBAR();
    o[d0] = __builtin_amdgcn_mfma_f32_32x32x16_bf16(ks == 0 ? pa0 : ks == 1 ? pa1 : ks == 2 ? pa2 : pa3, PKF(L[sl], H[sl]), o[d0], 0, 0, 0);
    if constexpr (EXPS) { c0[I] = __builtin_amdgcn_exp2f(c0[I]); if constexpr (I >= 1) ps += c0[I - 1];
        if constexpr (I == 9) { cv[0] = cvt_pk_bf16(c0[0], c0[1]); cv[1] = cvt_pk_bf16(c0[2], c0[3]); cv[2] = cvt_pk_bf16(c0[4], c0[5]); cv[3] = cvt_pk_bf16(c0[6], c0[7]); }
        if constexpr (I == 10) { auto r0 = __builtin_amdgcn_permlane32_swap(cv[0], cv[2], false, false); auto r1 = __builtin_amdgcn_permlane32_swap(cv[1], cv[3], false, false);
            u32x4 w = {r0[0], r1[0], r0[1], r1[1]}; ca0 = *reinterpret_cast<bf16x8*>(&w); } }
    if constexpr (I + 4 < 16) { SBAR(); L[sl] = tr_read<v_rd_off((I + 4) & 3, (I + 4) >> 2, 0)>(vb); H[sl] = tr_read<v_rd_off((I + 4) & 3, (I + 4) >> 2, 1)>(vb); }
}
__device__ __forceinline__ void pv_window0(int vb, s16x4 (&L)[4], s16x4 (&H)[4]) {
    L[0] = tr_read<v_rd_off(0, 0, 0)>(vb); H[0] = tr_read<v_rd_off(0, 0, 1)>(vb); L[1] = tr_read<v_rd_off(1, 0, 0)>(vb); H[1] = tr_read<v_rd_off(1, 0, 1)>(vb);
    L[2] = tr_read<v_rd_off(2, 0, 0)>(vb); H[2] = tr_read<v_rd_off(2, 0, 1)>(vb); L[3] = tr_read<v_rd_off(3, 0, 0)>(vb); H[3] = tr_read<v_rd_off(3, 0, 1)>(vb);
}
template <bool EXPS> __device__ __forceinline__ void pv_roll(f32x16* o, int vb, const bf16x8& pa0, const bf16x8& pa1, const bf16x8& pa2, const bf16x8& pa3, s16x4 (&L)[4], s16x4 (&H)[4], f32x16& c0, float& l_reg, bf16x8& ca0, bf16x8& ca1) {
    float ps = 0.f; unsigned cv[4] = {0u, 0u, 0u, 0u};
    pv_roll_step<0, EXPS>(o, vb, pa0, pa1, pa2, pa3, L, H, c0, ps, cv, ca0);   pv_roll_step<1, EXPS>(o, vb, pa0, pa1, pa2, pa3, L, H, c0, ps, cv, ca0);   pv_roll_step<2, EXPS>(o, vb, pa0, pa1, pa2, pa3, L, H, c0, ps, cv, ca0);   pv_roll_step<3, EXPS>(o, vb, pa0, pa1, pa2, pa3, L, H, c0, ps, cv, ca0);
    pv_roll_step<4, EXPS>(o, vb, pa0, pa1, pa2, pa3, L, H, c0, ps, cv, ca0);   pv_roll_step<5, EXPS>(o, vb, pa0, pa1, pa2, pa3, L, H, c0, ps, cv, ca0);   pv_roll_step<6, EXPS>(o, vb, pa0, pa1, pa2, pa3, L, H, c0, ps, cv, ca0);   pv_roll_step<7, EXPS>(o, vb, pa0, pa1, pa2, pa3, L, H, c0, ps, cv, ca0);
    pv_roll_step<8, EXPS>(o, vb, pa0, pa1, pa2, pa3, L, H, c0, ps, cv, ca0);   pv_roll_step<9, EXPS>(o, vb, pa0, pa1, pa2, pa3, L, H, c0, ps, cv, ca0);   pv_roll_step<10, EXPS>(o, vb, pa0, pa1, pa2, pa3, L, H, c0, ps, cv, ca0);  pv_roll_step<11, EXPS>(o, vb, pa0, pa1, pa2, pa3, L, H, c0, ps, cv, ca0);
    pv_roll_step<12, EXPS>(o, vb, pa0, pa1, pa2, pa3, L, H, c0, ps, cv, ca0);  pv_roll_step<13, EXPS>(o, vb, pa0, pa1, pa2, pa3, L, H, c0, ps, cv, ca0);  pv_roll_step<14, EXPS>(o, vb, pa0, pa1, pa2, pa3, L, H, c0, ps, cv, ca0);  pv_roll_step<15, EXPS>(o, vb, pa0, pa1, pa2, pa3, L, H, c0, ps, cv, ca0);
    SBAR();
    if constexpr (EXPS) { ps += c0[15]; l_reg += ps;
        unsigned a0 = cvt_pk_bf16(c0[8], c0[9]), a1 = cvt_pk_bf16(c0[10], c0[11]), b0 = cvt_pk_bf16(c0[12], c0[13]), b1 = cvt_pk_bf16(c0[14], c0[15]);
        auto r0 = __builtin_amdgcn_permlane32_swap(a0, b0, false, false); auto r1 = __builtin_amdgcn_permlane32_swap(a1, b1, false, false);
        u32x4 w = {r0[0], r1[0], r0[1], r1[1]}; ca1 = *reinterpret_cast<bf16x8*>(&w); }
}
template <int OFF> __device__ __forceinline__ bf16x8 k_read(int ka) { bf16x8 r; asm volatile("ds_read_b128 %0, %1 offset:%2" : "=&v"(r) : "v"(ka), "i"(OFF) : "memory"); return r; }
template <int I> __device__ __forceinline__ void qkt_roll_step(f32x16& c0, f32x16& c1, const int (&ka)[4], const bf16x8* qr, const f32x16& negm, bf16x8 (&kb)[4], f32x16& p1, float& ps, unsigned (&cv)[4], bf16x8& pa2) {
    constexpr int d0 = I >> 1, sl = I & 3, rem = 7 - I, n = rem < 3 ? rem : 3;
    asm volatile("s_waitcnt lgkmcnt(%0)" :: "n"(n) : "memory"); SBAR();
    if constexpr ((I & 1) == 0) { if constexpr (d0 == 0) c0 = __builtin_amdgcn_mfma_f32_32x32x16_bf16(kb[sl], qr[0], negm, 0, 0, 0); else c0 = __builtin_amdgcn_mfma_f32_32x32x16_bf16(kb[sl], qr[d0], c0, 0, 0, 0); }
    else { if constexpr (d0 == 0) c1 = __builtin_amdgcn_mfma_f32_32x32x16_bf16(kb[sl], qr[0], negm, 0, 0, 0); else c1 = __builtin_amdgcn_mfma_f32_32x32x16_bf16(kb[sl], qr[d0], c1, 0, 0, 0); }
    p1[2 * I] = __builtin_amdgcn_exp2f(p1[2 * I]); p1[2 * I + 1] = __builtin_amdgcn_exp2f(p1[2 * I + 1]);
    if constexpr (I >= 1) ps += p1[2 * I - 2] + p1[2 * I - 1];
    if constexpr (I == 5) { cv[0] = cvt_pk_bf16(p1[0], p1[1]); cv[1] = cvt_pk_bf16(p1[2], p1[3]); cv[2] = cvt_pk_bf16(p1[4], p1[5]); cv[3] = cvt_pk_bf16(p1[6], p1[7]); }
    if constexpr (I == 6) { auto r0 = __builtin_amdgcn_permlane32_swap(cv[0], cv[2], false, false); auto r1 = __builtin_amdgcn_permlane32_swap(cv[1], cv[3], false, false);
        u32x4 w = {r0[0], r1[0], r0[1], r1[1]}; pa2 = *reinterpret_cast<bf16x8*>(&w); }
    if constexpr (I + 4 < 8) { SBAR(); kb[sl] = k_read<((I + 4) & 1) * 4096>(ka[(I + 4) >> 1]); }
}
__device__ __forceinline__ void qkt_roll(f32x16& c0, f32x16& c1, const int (&ka)[4], const bf16x8* qr, const f32x16& negm, f32x16& p1, float& l_reg, bf16x8& pa2, bf16x8& pa3) {
    bf16x8 kb[4]; float ps = 0.f; unsigned cv[4] = {0u, 0u, 0u, 0u};
    kb[0] = k_read<0>(ka[0]); kb[1] = k_read<4096>(ka[0]); kb[2] = k_read<0>(ka[1]); kb[3] = k_read<4096>(ka[1]);
    qkt_roll_step<0>(c0, c1, ka, qr, negm, kb, p1, ps, cv, pa2); qkt_roll_step<1>(c0, c1, ka, qr, negm, kb, p1, ps, cv, pa2); qkt_roll_step<2>(c0, c1, ka, qr, negm, kb, p1, ps, cv, pa2); qkt_roll_step<3>(c0, c1, ka, qr, negm, kb, p1, ps, cv, pa2);
    qkt_roll_step<4>(c0, c1, ka, qr, negm, kb, p1, ps, cv, pa2); qkt_roll_step<5>(c0, c1, ka, qr, negm, kb, p1, ps, cv, pa2); qkt_roll_step<6>(c0, c1, ka, qr, negm, kb, p1, ps, cv, pa2); qkt_roll_step<7>(c0, c1, ka, qr, negm, kb, p1, ps, cv, pa2);
    SBAR();
    ps += p1[14] + p1[15]; l_reg += ps;
    { unsigned a0 = cvt_pk_bf16(p1[8], p1[9]), a1 = cvt_pk_bf16(p1[10], p1[11]), b0 = cvt_pk_bf16(p1[12], p1[13]), b1 = cvt_pk_bf16(p1[14], p1[15]);
      auto r0 = __builtin_amdgcn_permlane32_swap(a0, b0, false, false); auto r1 = __builtin_amdgcn_permlane32_swap(a1, b1, false, false);
      u32x4 w = {r0[0], r1[0], r0[1], r1[1]}; pa3 = *reinterpret_cast<bf16x8*>(&w); }
}
__device__ __forceinline__ void partialSM_tail(f32x16& p0, float& l_reg, bf16x8& pa0, bf16x8& pa1) {
    float ps = 0;
#pragma unroll
    for (int r = 0; r < 16; ++r) ps += p0[r];
    l_reg += ps;
#define PK4(P, BASE, OUT) do { unsigned a0 = cvt_pk_bf16(P[BASE + 0], P[BASE + 1]), a1 = cvt_pk_bf16(P[BASE + 2], P[BASE + 3]);   \
    unsigned b0 = cvt_pk_bf16(P[BASE + 4], P[BASE + 5]), b1 = cvt_pk_bf16(P[BASE + 6], P[BASE + 7]);                              \
    auto r0 = __builtin_amdgcn_permlane32_swap(a0, b0, false, false); auto r1 = __builtin_amdgcn_permlane32_swap(a1, b1, false, false); \
    u32x4 w = {r0[0], r1[0], r0[1], r1[1]}; OUT = *reinterpret_cast<bf16x8*>(&w); } while (0)
    PK4(p0, 0, pa0); PK4(p0, 8, pa1);
#undef PK4
}
#undef PKF
template <bool SECOND>
__device__ __forceinline__ void attn_unit(const bf16_t* __restrict__ Qb, const bf16_t* __restrict__ Kh, const bf16_t* __restrict__ Vh, bf16_t* O1, bf16_t* Hd, float lam, const float* subln, int seq, float KN, char* lds, LAS unsigned char* ldsl, const int wave_s) {
    int tid = wave_s * 64 + lane_id_opaque(); asm volatile("" : "+v"(tid));
    const int wid = __builtin_amdgcn_readfirstlane(tid >> 6), lane = tid & 63, r32 = lane & 31, hi = lane >> 5;
    constexpr int KOFF = NBUF * SHM_V;
    char* V_lds = lds; char* K_lds = lds + KOFF;
    float* ws = (float*)(lds + NBUF * SHM_V + NBUF * SHM_K) + wid * 64; float* li_l = ws;
    float l_reg = 0; f32x16 o[4] = {}; bf16x8 qr[4];
    const bf16_t* Qw = Qb + (long)(wid * QBLK + r32) * LDQKV + hi * 8;
#pragma unroll
    for (int d0 = 0; d0 < 4; ++d0) qr[d0] = *reinterpret_cast<const bf16x8*>(Qw + d0 * 16);
    unsigned kgo, vgo0, vgo1;
    { const int row = wid * 8 + (lane >> 3), colB = ((lane & 7) * 16) ^ (((row >> 1) & 7) << 4);
      kgo = (unsigned)(row * LDQKV * 2 + colB);
      const int st0 = wid * 2 + (lane >> 5), st1 = 16 + st0, klo = (lane & 31) >> 2, cl = (lane & 3) * 8;
      const int kk0 = (st0 >> 2) * 8 + klo, kk1 = (st1 >> 2) * 8 + klo;
      const int k0 = (kk0 & ~0xC) | ((kk0 & 4) << 1) | ((kk0 & 8) >> 1), k1 = (kk1 & ~0xC) | ((kk1 & 4) << 1) | ((kk1 & 8) >> 1);
      const unsigned dv = (unsigned)((const char*)Vh - (const char*)Kh);
      vgo0 = dv + (unsigned)((k0 * LDQKV + (st0 & 3) * 32 + cl) * 2); vgo1 = dv + (unsigned)((k1 * LDQKV + (st1 & 3) * 32 + cl) * 2); }
#define DMA(t, slot) do { const char* gb_ = (const char*)Kh + (size_t)(t) * (KVBLK * LDQKV * 2); \
    __builtin_amdgcn_global_load_lds((const unsigned*)(gb_ + kgo), (LAS unsigned*)(ldsl + KOFF + (slot) * SHM_K + wid * 1024), 16, 0, 0); \
    __builtin_amdgcn_global_load_lds((const unsigned*)(gb_ + vgo0), (LAS unsigned*)(ldsl + (slot) * SHM_V + wid * 1024), 16, 0, 0); \
    __builtin_amdgcn_global_load_lds((const unsigned*)(gb_ + vgo1), (LAS unsigned*)(ldsl + (slot) * SHM_V + 8192 + wid * 1024), 16, 0, 0); } while (0)
#define WAIT_BAR(N) asm volatile("s_waitcnt vmcnt(" #N ") lgkmcnt(0)\n\ts_barrier" ::: "memory")
    DMA(0, 0); DMA(1, 1);
    f32x16 negm;
    { float ss = 0.f;
#pragma unroll
      for (int d0 = 0; d0 < 4; ++d0)
#pragma unroll
          for (int e = 0; e < 8; ++e) { const float v = __uint_as_float(((unsigned)(unsigned short)qr[d0][e]) << 16); ss += v * v; }
      auto rr = __builtin_amdgcn_permlane32_swap(__float_as_uint(ss), __float_as_uint(ss), false, false);
      ss = __uint_as_float(rr[0]) + __uint_as_float(rr[1]);
      const float nb = -sqrtf(ss) * KN;
#pragma unroll
      for (int r = 0; r < 16; ++r) negm[r] = nb; }
    const int vb0 = (int)(uintptr_t)V_lds + v_rd_base(lane);
    int ka0[4];
#pragma unroll
    for (int d0 = 0; d0 < 4; ++d0) ka0[d0] = (int)(uintptr_t)K_lds + KSWZ64(r32, d0 * 32 + hi * 16);
    f32x16 pA0, pA1, pB0, pB1; bf16x8 paA0, paA1, paB0, paB1, pa2, pa3; const int NT = seq / KVBLK;
    const bool grpB = false;
    WAIT_BAR(3);
    DMA(2, 2);
    qkt(pA0, pA1, K_lds, qr, negm, r32, hi); partialSM(pA0, l_reg, paA0, paA1);
    WAIT_BAR(3);
    if (grpB) WAIT_BAR(3);
#define STEP(j, C0, C1, CA0, CA1, P1, PA0, PA1) do { \
        if ((j) + 2 < NT) DMA((j) + 2, ((j) + 2) & 3); \
        const int vb_ = vb0 + (((j) - 1) & 3) * SHM_V; \
        SBAR(); pv_window0(vb_, VL, VH); SBAR(); \
        { const int ko_ = ((j) & 3) * SHM_K; const int ka_[4] = {ka0[0] + ko_, ka0[1] + ko_, ka0[2] + ko_, ka0[3] + ko_}; \
          qkt_roll(C0, C1, ka_, qr, negm, P1, l_reg, pa2, pa3); } SBAR(); \
        pv_roll<true>(o, vb_, PA0, PA1, pa2, pa3, VL, VH, C0, l_reg, CA0, CA1); SBAR(); \
        if ((j) + 2 < NT) WAIT_BAR(3); else WAIT_BAR(0); } while (0)
    s16x4 VL[4], VH[4];
    for (int j = 1; j + 1 < NT; j += 2) {
        STEP(j, pB0, pB1, paB0, paB1, pA1, paA0, paA1);
        STEP(j + 1, pA0, pA1, paA0, paA1, pB1, paB0, paB1);
    }
    STEP(NT - 1, pB0, pB1, paB0, paB1, pA1, paA0, paA1);
    finishSM(pB1, l_reg, pa2, pa3); SBAR();
    pv_window0(vb0 + ((NT - 1) & 3) * SHM_V, VL, VH);
    pv_roll<false>(o, vb0 + ((NT - 1) & 3) * SHM_V, paB0, paB1, pa2, pa3, VL, VH, pB0, l_reg, paB0, paB1);
    if (!grpB) WAIT_BAR(0);
#undef STEP
    { auto rr = __builtin_amdgcn_permlane32_swap(__float_as_uint(l_reg), __float_as_uint(l_reg), false, false); l_reg = __uint_as_float(rr[0]) + __uint_as_float(rr[1]); }
    if (hi == 0) li_l[r32] = l_reg; asm volatile("s_waitcnt lgkmcnt(0)" ::: "memory");
    float rli[16];
#pragma unroll
    for (int r = 0; r < 16; ++r) rli[r] = __builtin_amdgcn_rcpf(li_l[crow(r, hi)]);
#define ROWWALK(PTR, r) do { PTR += ((r) & 3) == 3 ? 5 * 1024 : 1024; asm volatile("" : "+v"(PTR)); } while (0)
    const long lane_off = (long)(wid * QBLK + 4 * hi) * 1024 + r32;
    if constexpr (!SECOND) {
        bf16_t* pw = O1 + lane_off; asm volatile("" : "+v"(pw));
#pragma unroll
        for (int r = 0; r < 16; ++r) {
#pragma unroll
            for (int d0 = 0; d0 < 4; ++d0) pw[d0 * 32] = (bf16_t)(cvt_pk_bf16(o[d0][r] * rli[r], 0.f) & 0xffffu);
            ROWWALK(pw, r); }
    } else {
        float sw[4];
#pragma unroll
        for (int d0 = 0; d0 < 4; ++d0) sw[d0] = subln[d0 * 32 + r32] * 0.8f;
        const bf16_t* pr = O1 + lane_off; asm volatile("" : "+v"(pr));
        float ssr[16];
#pragma unroll
        for (int r = 0; r < 16; ++r) { float sq = 0.f;
#pragma unroll
            for (int d0 = 0; d0 < 4; ++d0) { const float o1v = __uint_as_float(((unsigned)pr[d0 * 32]) << 16);
                const float y = o1v - lam * (o[d0][r] * rli[r]); o[d0][r] = y; sq += y * y; }
            ssr[r] = sq; ROWWALK(pr, r); }
#pragma unroll
        for (int m = 1; m < 32; m <<= 1)
#pragma unroll
            for (int r = 0; r < 16; ++r) ssr[r] += __shfl_xor(ssr[r], m);
        bf16_t* pw = Hd + lane_off; asm volatile("" : "+v"(pw));
#pragma unroll
        for (int r = 0; r < 16; ++r) { const float rstd = rsqrtf(ssr[r] * (1.f / 128.f) + EPS);
#pragma unroll
            for (int d0 = 0; d0 < 4; ++d0) pw[d0 * 32] = (bf16_t)(cvt_pk_bf16(o[d0][r] * rstd * sw[d0], 0.f) & 0xffffu);
            ROWWALK(pw, r); }
    }
#undef ROWWALK
    WAIT_BAR(0);
#undef DMA
#undef WAIT_BAR
}
#undef SBAR
}

struct Args { const float* in[23]; float* out; unsigned char* ws; int lo, hi; };
enum { I_X = 0, I_C, I_CTX, I_CCTX, I_WMOD, I_BMOD, I_NAW, I_WIN, I_QNW, I_KNW, I_LQ1, I_LK1, I_LQ2, I_LK2, I_SUBLN, I_POOLW, I_POOLS, I_WA, I_WB, I_WO, I_NMW, I_FF1, I_FF2 };
constexpr int LDS_BYTES = 131072 + 1024;

__device__ __forceinline__ void p0_transpose_item(const float* W, int K, int N, bf16_t* WT, LAS float* scr, int item, int lane) {
    const int nblk = N / 32, kb = item / nblk, nb = item % nblk, k0 = 64 * kb, n0 = 32 * nb;
#pragma unroll 8
    for (int i = 0; i < 32; ++i) { const int kk = 2 * i + (lane >> 5); scr[kk * 33 + (lane & 31)] = W[(size_t)(k0 + kk) * N + n0 + (lane & 31)]; }
    asm volatile("s_waitcnt lgkmcnt(0)" ::: "memory");
    const int c = lane & 7;
#pragma unroll
    for (int j = 0; j < 4; ++j) { const int n = (lane >> 3) + 8 * j; const LAS float* s = scr + (8 * c) * 33 + n;
        u32x4 o; o.x = cvt_pk_bf16(s[0 * 33], s[1 * 33]); o.y = cvt_pk_bf16(s[2 * 33], s[3 * 33]); o.z = cvt_pk_bf16(s[4 * 33], s[5 * 33]); o.w = cvt_pk_bf16(s[6 * 33], s[7 * 33]);
        *(u32x4*)(WT + (size_t)(n0 + n) * K + k0 + 8 * c) = o; }
    asm volatile("s_waitcnt lgkmcnt(0)" ::: "memory");
}

template <typename XT>
__device__ __forceinline__ void modulate_rows(const XT* X, int nrows, int rpw, const float* nw, const float* mod, int shift_off, int scale_off, int rows_per_batch, bf16_t* out, int gw, int NGW, int lane) {
    for (int m0 = gw * rpw; m0 < nrows; m0 += NGW * rpw) {
        const int r = rows_per_batch ? m0 / rows_per_batch : 4;
        const float* mr = mod + (size_t)r * NMOD;
        for (int mi = 0; mi < rpw; mi += 2) {
            const int m = m0 + mi;
            f32x4 v[2][8];
            if constexpr (sizeof(XT) == 4) {
#pragma unroll
                for (int q = 0; q < 2; ++q) { const f32x4* xr = (const f32x4*)((const float*)X + (size_t)(m + q) * DM) + lane;
#pragma unroll
                    for (int j = 0; j < 8; ++j) v[q][j] = __builtin_nontemporal_load(xr + 64 * j); }
            } else {
                u32x2 w[2][8];
#pragma unroll
                for (int q = 0; q < 2; ++q) { const u32x2* xr = (const u32x2*)((const bf16_t*)X + (size_t)(m + q) * DM) + lane;
#pragma unroll
                    for (int j = 0; j < 8; ++j) w[q][j] = xr[64 * j]; }
#pragma unroll
                for (int q = 0; q < 2; ++q)
#pragma unroll
                    for (int j = 0; j < 8; ++j) v[q][j] = (f32x4){bflo(w[q][j].x), bfhi(w[q][j].x), bflo(w[q][j].y), bfhi(w[q][j].y)};
            }
            float rstd[2];
#pragma unroll
            for (int q = 0; q < 2; ++q) { float ss = 0.f;
#pragma unroll
                for (int j = 0; j < 8; ++j) ss += (v[q][j].x * v[q][j].x + v[q][j].y * v[q][j].y) + (v[q][j].z * v[q][j].z + v[q][j].w * v[q][j].w);
                rstd[q] = rsqrtf(wave_sum(ss) * (1.f / DM) + EPS); }
#pragma unroll
            for (int j = 0; j < 8; ++j) { const int col = (lane + 64 * j) * 4;
                const f32x4 Ac = *(const f32x4*)(nw + col) * (*(const f32x4*)(mr + scale_off + col) + 1.0f), Bc = *(const f32x4*)(mr + shift_off + col);
#pragma unroll
                for (int q = 0; q < 2; ++q) { const f32x4 y = (v[q][j] * rstd[q]) * Ac + Bc;
                    u32x2 o; o.x = cvt_pk_bf16(y.x, y.y); o.y = cvt_pk_bf16(y.z, y.w);
                    *(u32x2*)(out + (size_t)(m + q) * DM + col) = o; } }
        }
    }
}

__device__ __forceinline__ void grid_bar(unsigned* ctr, unsigned target, int tid) {
    asm volatile("s_waitcnt vmcnt(0) lgkmcnt(0)" ::: "memory");
    __syncthreads();
    if (tid == 0) {
        __builtin_amdgcn_fence(__ATOMIC_RELEASE, "agent");
        asm volatile("s_waitcnt vmcnt(0)" ::: "memory");
        __hip_atomic_fetch_add(ctr, 1u, __ATOMIC_RELAXED, __HIP_MEMORY_SCOPE_AGENT);
        while (__hip_atomic_load(ctr, __ATOMIC_RELAXED, __HIP_MEMORY_SCOPE_AGENT) < target) __builtin_amdgcn_s_sleep(1);
        __builtin_amdgcn_fence(__ATOMIC_ACQUIRE, "agent");
        asm volatile("s_waitcnt vmcnt(0)" ::: "memory");
    }
    __syncthreads();
}

__global__ void __launch_bounds__(512, 2) fwd_kernel(Args args) {
    extern __shared__ __attribute__((aligned(16))) unsigned char lds[];
    LAS unsigned char* ldsl = (LAS unsigned char*)lds;
    int wave_k = __builtin_amdgcn_readfirstlane((int)threadIdx.x >> 6); asm volatile("" : "+s"(wave_k));
    int lo, hi;
    { const Args __attribute__((address_space(4)))* A0 = (const Args __attribute__((address_space(4)))*)(unsigned long long)__builtin_amdgcn_kernarg_segment_ptr(); lo = A0->lo; hi = A0->hi; }
#define PH_VARS \
    const Args __attribute__((address_space(4)))* A_; { unsigned long long kp_ = (unsigned long long)__builtin_amdgcn_kernarg_segment_ptr(); asm volatile("" : "+s"(kp_)); A_ = (const Args __attribute__((address_space(4)))*)kp_; } \
    int tid = wave_k * 64 + lane_id_opaque(); asm volatile("" : "+v"(tid)); \
    const int lane = tid & 63, wave = __builtin_amdgcn_readfirstlane(tid >> 6); \
    const int G = gridDim.x, bx = blockIdx.x; \
    const int vcu = (G % 8 == 0) ? (bx % 8) * (G / 8) + bx / 8 : bx; \
    const int gw = vcu * 8 + wave, NGW = G * 8; \
    unsigned char* ws = A_->ws; \
    float* mod = (float*)(ws + WS_MOD); float* rope = (float*)(ws + WS_ROPE); \
    bf16_t* Win_t = (bf16_t*)(ws + WS_WIN); bf16_t* Wff1_t = (bf16_t*)(ws + WS_WFF1); bf16_t* Wff2_t = (bf16_t*)(ws + WS_WFF2); bf16_t* Wo_t = (bf16_t*)(ws + WS_WO); \
    bf16_t* Wa_t = (bf16_t*)(ws + WS_WA); bf16_t* Wb_t = (bf16_t*)(ws + WS_WB); bf16_t* Wp_t = (bf16_t*)(ws + WS_WP); \
    bf16_t* Hb = (bf16_t*)(ws + WS_H); bf16_t* HCb = (bf16_t*)(ws + WS_HC); bf16_t* QKV = (bf16_t*)(ws + WS_QKV); bf16_t* PG = (bf16_t*)(ws + WS_PG); \
    bf16_t* Db = (bf16_t*)(ws + WS_D); bf16_t* POOLED = (bf16_t*)(ws + WS_POOLED); bf16_t* OSUB = (bf16_t*)(ws + WS_OSUB); \
    bf16_t* HEADS = (bf16_t*)(ws + WS_HEADS); bf16_t* X1 = (bf16_t*)(ws + WS_X1); (void)X1; bf16_t* Mb = (bf16_t*)(ws + WS_M); bf16_t* H2 = (bf16_t*)(ws + WS_H2); bf16_t* Ub = (bf16_t*)(ws + WS_U); \
    (void)lane; (void)wave; (void)gw; (void)NGW; (void)mod; (void)rope; (void)Win_t; (void)Wff1_t; (void)Wff2_t; (void)Wo_t; (void)Wa_t; (void)Wb_t; (void)Wp_t; (void)Hb; (void)HCb; (void)QKV; (void)PG; \
    (void)Db; (void)POOLED; (void)OSUB; (void)HEADS; (void)Mb; (void)H2; (void)Ub; (void)bx; (void)vcu;
#ifndef PH_MASK
#define PH_MASK 0x3ff
#endif
#define IN(k) (((PH_MASK >> (k)) & 1) && lo <= (k) && (k) < hi)
#define SEAM(k) do { if (IN(k) && IN((k) + 1)) { if ((k) == 0) { cg::this_grid().sync(); } else { \
        const Args __attribute__((address_space(4)))* Ab_ = (const Args __attribute__((address_space(4)))*)(unsigned long long)__builtin_amdgcn_kernarg_segment_ptr(); \
        grid_bar((unsigned*)(Ab_->ws + WS_BAR), (unsigned)(k) * gridDim.x, wave_k * 64 + lane_id_opaque()); } } } while (0)

    if (IN(0)) { PH_VARS;
        {
            float* sc = (float*)lds;
            const float* c = A_->in[I_C]; const float* cc = A_->in[I_CCTX];
            for (int i = tid; i < 5 * DM; i += 512) { const int r = i / DM, k = i % DM; const float v = (r < 4) ? c[r * DM + k] : cc[k]; sc[i] = v / (1.0f + __expf(-v)); }
            __syncthreads();
            const float* wm = A_->in[I_WMOD]; const float* bm = A_->in[I_BMOD];
            float* red = (float*)(lds + 40960);
            for (int cb = bx; cb < NMOD / 48; cb += G) {
                const int col0 = cb * 48;
                if (tid < 504) {
                    const int cgp = tid % 12, ks = tid / 12;
                    float a[5][4];
#pragma unroll
                    for (int r = 0; r < 5; ++r)
#pragma unroll
                        for (int j = 0; j < 4; ++j) a[r][j] = 0.f;
                    for (int k = ks; k < DM; k += 42) {
                        const f32x4 w = *(const f32x4*)(wm + (size_t)k * NMOD + col0 + cgp * 4);
#pragma unroll
                        for (int r = 0; r < 5; ++r) { const float s = sc[r * DM + k]; a[r][0] += s * w.x; a[r][1] += s * w.y; a[r][2] += s * w.z; a[r][3] += s * w.w; }
                    }
#pragma unroll
                    for (int r = 0; r < 5; ++r)
#pragma unroll
                        for (int j = 0; j < 4; ++j) red[(r * 4 + j) * 504 + tid] = a[r][j];
                }
                __syncthreads();
                if (tid < 240) { const int r = tid / 48, ccol = tid % 48, cgp = ccol / 4, j = ccol % 4; float s = 0.f;
                    for (int ks = 0; ks < 42; ++ks) s += red[(r * 4 + j) * 504 + ks * 12 + cgp];
                    mod[r * NMOD + col0 + ccol] = s + bm[col0 + ccol]; }
                __syncthreads();
            }
            if (bx == 0 && tid == 0) __hip_atomic_store((unsigned*)(ws + WS_BAR), 0u, __ATOMIC_RELAXED, __HIP_MEMORY_SCOPE_AGENT);
            if (bx == 0) for (int i = tid; i < 128 * 16; i += 512) { const int pos = i >> 4, f = i & 15;
                const float inv = powf(10000.0f, -(float)(2 * f) / 32.0f); float sn, cs; sincosf((float)pos * inv, &sn, &cs); rope[2 * i] = cs; rope[2 * i + 1] = sn; }
            __syncthreads();
        }
        LAS float* scr = (LAS float*)(ldsl + wave * 16384);
        constexpr int I_IN = (DM / 64) * (INW / 32), I_F1 = (DM / 64) * (DFF / 32), I_F2 = (DFF / 64) * (DM / 32), I_O = (DM / 64) * (DM / 32), I_A = (1024 / 64) * (DM / 32), I_P = 4 * 8;
        constexpr int NITEMS = I_IN + I_F1 + I_F2 + I_O + 2 * I_A + 4 * I_P;
        for (int it = gw; it < NITEMS; it += NGW) {
            int r = it;
            if (r < I_IN) { p0_transpose_item(A_->in[I_WIN], DM, INW, Win_t, scr, r, lane); continue; } r -= I_IN;
            if (r < I_F1) { p0_transpose_item(A_->in[I_FF1], DM, DFF, Wff1_t, scr, r, lane); continue; } r -= I_F1;
            if (r < I_F2) { p0_transpose_item(A_->in[I_FF2], DFF, DM, Wff2_t, scr, r, lane); continue; } r -= I_F2;
            if (r < I_O) { p0_transpose_item(A_->in[I_WO], DM, DM, Wo_t, scr, r, lane); continue; } r -= I_O;
            if (r < I_A) { p0_transpose_item(A_->in[I_WA], 1024, DM, Wa_t, scr, r, lane); continue; } r -= I_A;
            if (r < I_A) { p0_transpose_item(A_->in[I_WB], 1024, DM, Wb_t, scr, r, lane); continue; } r -= I_A;
            const int gq = r / I_P; r -= gq * I_P;
            p0_transpose_item(A_->in[I_POOLW] + (size_t)gq * 65536, 256, 256, Wp_t + (size_t)gq * 65536, scr, r, lane);
        }
    }
    SEAM(0);
    if (IN(1)) { PH_VARS;
        modulate_rows<float>(A_->in[I_X], MTOK, 16, A_->in[I_NAW], mod, 0, DM, SEQ, Hb, gw, NGW, lane);
        modulate_rows<float>(A_->in[I_CTX], NB * CTX, 4, A_->in[I_NAW], mod, 0, DM, 0, HCb, gw, NGW, lane);
    }
    SEAM(1);
    if (IN(2)) { PH_VARS;
        { pg8::Gemm g{Hb, Win_t, MTOK, INW, DM, DM, DM, 0, 128, 128}; pg8::StaticOrder S; S.init(MTOK, INW, G, bx);
          pg8::Epi<pg8::E_G1> E{QKV, PG, nullptr, nullptr, nullptr, nullptr};
          pg8::gemm_phase(tid, ldsl, g, S, E); }
        { pg8::Gemm g{HCb, Win_t + (size_t)1024 * DM, NB * CTX, 2048, DM, DM, DM, 0, 128, 128}; pg8::StaticOrder S; S.init(NB * CTX, 2048, G, bx);
          pg8::Epi<pg8::E_CTX> E{QKV, nullptr, nullptr, nullptr, nullptr, nullptr};
          pg8::gemm_phase(tid, ldsl, g, S, E); }
    }
    SEAM(2);
    if (IN(3)) { PH_VARS;
        const float* qnw = A_->in[I_QNW]; const float* knw = A_->in[I_KNW];
        for (int R = gw; R < MKV; R += NGW) {
            const int t = R % SKV; const bool isc = t >= SEQ;
            const int head = lane >> 1, half = lane & 1;
            bf16_t* p = QKV + (size_t)R * LDQKV + head * 64 + half * 32;
            float y[32];
            { const u32x4 a = *(const u32x4*)p, b = *(const u32x4*)(p + 8), c = *(const u32x4*)(p + 16), d = *(const u32x4*)(p + 24);
              const unsigned w[16] = {a.x, a.y, a.z, a.w, b.x, b.y, b.z, b.w, c.x, c.y, c.z, c.w, d.x, d.y, d.z, d.w};
#pragma unroll
              for (int i = 0; i < 16; ++i) { y[2 * i] = bflo(w[i]); y[2 * i + 1] = bfhi(w[i]); } }
            float ss = 0.f;
#pragma unroll
            for (int i = 0; i < 32; ++i) ss += y[i] * y[i];
            ss += __shfl_xor(ss, 1);
            const float rstd = rsqrtf(ss * (1.f / 64.f) + EPS);
            const float* nw = (head < 16 ? qnw : knw) + half * 32;
#pragma unroll
            for (int i = 0; i < 32; ++i) y[i] = y[i] * rstd * nw[i];
            if (head < 16) {
#pragma unroll
                for (int i = 0; i < 32; ++i) y[i] *= att::QSCALE; }
            if (!isc) {
                const int pos = half ? (t & 63) : (t >> 6);
                const float* tb = rope + pos * 32;
#pragma unroll
                for (int i = 0; i < 16; ++i) { const float cs = tb[2 * i], sn = tb[2 * i + 1], a = y[i], b = y[i + 16]; y[i] = a * cs - b * sn; y[i + 16] = a * sn + b * cs; }
            }
            if (!isc || head >= 16) {
                u32x4 o[4];
#pragma unroll
                for (int q = 0; q < 4; ++q) { o[q].x = cvt_pk_bf16(y[8 * q], y[8 * q + 1]); o[q].y = cvt_pk_bf16(y[8 * q + 2], y[8 * q + 3]); o[q].z = cvt_pk_bf16(y[8 * q + 4], y[8 * q + 5]); o[q].w = cvt_pk_bf16(y[8 * q + 6], y[8 * q + 7]); }
                *(u32x4*)p = o[0]; *(u32x4*)(p + 8) = o[1]; *(u32x4*)(p + 16) = o[2]; *(u32x4*)(p + 24) = o[3];
            }
        }
        for (long it = (long)vcu * 512 + tid; it < (long)MTOK * 128; it += (long)G * 512) {
            const int row = (int)(it >> 7), ch = (int)(it & 127), gq = ch >> 5, w = 2 << gq;
            const int t = row & (SEQ - 1), rb = row - t;
            const int l0 = max(t - w / 2, 0), h0 = min(t + w - w / 2, SEQ);
            float s[8];
#pragma unroll
            for (int i = 0; i < 8; ++i) s[i] = 0.f;
            for (int tt = l0; tt < h0; ++tt) { const u32x4 a = *(const u32x4*)(PG + (size_t)(rb + tt) * LDPG + ch * 8);
                s[0] += bflo(a.x); s[1] += bfhi(a.x); s[2] += bflo(a.y); s[3] += bfhi(a.y); s[4] += bflo(a.z); s[5] += bfhi(a.z); s[6] += bflo(a.w); s[7] += bfhi(a.w); }
            const float inv = 1.0f / (float)(h0 - l0);
            const u32x4 a = *(const u32x4*)(PG + (size_t)row * LDPG + ch * 8);
            u32x4 o; o.x = cvt_pk_bf16(s[0] * inv - bflo(a.x), s[1] * inv - bfhi(a.x)); o.y = cvt_pk_bf16(s[2] * inv - bflo(a.y), s[3] * inv - bfhi(a.y));
            o.z = cvt_pk_bf16(s[4] * inv - bflo(a.z), s[5] * inv - bfhi(a.z)); o.w = cvt_pk_bf16(s[6] * inv - bflo(a.w), s[7] * inv - bfhi(a.w));
            *(u32x4*)(Db + (size_t)row * 1024 + ch * 8) = o;
        }
    }
    SEAM(3);
    if (IN(4)) { PH_VARS;
        { pg8::Gemm g{Db, Wp_t, MTOK, 1024, 256, 1024, 256, 256, 128, 128}; pg8::StaticOrder S; S.init(MTOK, 1024, G, bx);
          pg8::Epi<pg8::E_POOL> E{POOLED, nullptr, nullptr, nullptr, A_->in[I_POOLS], nullptr};
          pg8::gemm_phase(tid, ldsl, g, S, E); }
        __syncthreads();
    }
    if (IN(4)) { PH_VARS;
        float KN; { float w = fabsf(A_->in[I_KNW][lane]);
#pragma unroll
            for (int o = 1; o < 64; o <<= 1) w = fmaxf(w, __shfl_xor(w, o));
            KN = 8.0f * w * 1.01f; }
        const float l1 = wave_sum(A_->in[I_LQ1][lane] * A_->in[I_LK1][lane]), l2 = wave_sum(A_->in[I_LQ2][lane] * A_->in[I_LK2][lane]);
        const float lam_init = 0.2f, lam = __expf(l1) - __expf(l2) + lam_init;
        const float* subln = A_->in[I_SUBLN];
        for (int U = vcu; U < NB * 8 * (SEQ / 256); U += G) {
            const int bh = U >> 5, qb = U & 31, b = bh >> 3, h = bh & 7;
            const bf16_t* base = QKV + (size_t)b * SKV * LDQKV;
            const bf16_t* qp = base + (size_t)qb * 256 * LDQKV + h * 128; const bf16_t* kp = base + 1024 + h * 128; const bf16_t* vp = base + 2048 + h * 128;
            bf16_t* o1 = OSUB + (size_t)(b * SEQ + qb * 256) * 1024 + h * 128; bf16_t* hd = HEADS + (size_t)(b * SEQ + qb * 256) * 1024 + h * 128;
            att::attn_unit<false>(qp, kp, vp, o1, hd, lam, subln, SKV, KN, (char*)lds, ldsl, wave_k);
            att::attn_unit<true>(qp + 64, kp + 64, vp, o1, hd, lam, subln, SKV, KN, (char*)lds, ldsl, wave_k);
        }
    }
    SEAM(4);
    if (IN(5)) { PH_VARS;
        { pg8::Gemm g{HEADS, Wa_t, MTOK, DM, 1024, 1024, 1024, 0, 128, 128}; pg8::StaticOrder S; S.init(MTOK, DM, G, bx);
          pg8::Epi<pg8::E_YA> E{Mb, nullptr, nullptr, nullptr, nullptr, PG};
          pg8::gemm_phase(tid, ldsl, g, S, E); }
        __syncthreads();
        { pg8::Gemm g{POOLED, Wb_t, MTOK, DM, 1024, 1024, 1024, 0, 128, 128}; pg8::StaticOrder S; S.init(MTOK, DM, G, bx);
          pg8::Epi<pg8::E_YB> E{Mb, nullptr, nullptr, nullptr, nullptr, PG};
          pg8::gemm_phase(tid, ldsl, g, S, E); }
    }
    SEAM(5);
    if (IN(6)) { PH_VARS;
        pg8::Gemm g{Mb, Wo_t, MTOK, DM, DM, DM, DM, 0, 128, 128}; pg8::StaticOrder S; S.init(MTOK, DM, G, bx);
        pg8::Epi<pg8::E_WO> E{X1, nullptr, nullptr, A_->in[I_X], mod + 2 * DM, nullptr};
        pg8::gemm_phase(tid, ldsl, g, S, E);
    }
    SEAM(6);
    if (IN(7)) { PH_VARS; modulate_rows<bf16_t>(X1, MTOK, 16, A_->in[I_NMW], mod, 3 * DM, 4 * DM, SEQ, H2, gw, NGW, lane); }
    SEAM(7);
    if (IN(8)) { PH_VARS;
        pg8::Gemm g{H2, Wff1_t, MTOK, DFF, DM, DM, DM, 0, 128, 128}; pg8::StaticOrder S; S.init(MTOK, DFF, G, bx);
        pg8::Epi<pg8::E_FF1> E{Ub, nullptr, nullptr, nullptr, nullptr, nullptr};
        pg8::gemm_phase(tid, ldsl, g, S, E);
    }
    SEAM(8);
    if (IN(9)) { PH_VARS;
        pg8::Gemm g{Ub, Wff2_t, MTOK, DM, DFF, 64, DFF, 0, (size_t)MTOK * 128, 128};   pg8::StaticOrder S; S.init(MTOK, DM, G, bx);
        pg8::Epi<pg8::E_FF2> E{nullptr, nullptr, A_->out, nullptr, mod + 5 * DM, X1};
        pg8::gemm_phase(tid, ldsl, g, S, E);
    }
#undef IN
#undef SEAM
}

extern "C" void kernel_launch(void* const* d_in, const int* in_sizes, int n_in, void* d_out, int out_size, void* d_ws, size_t ws_size, hipStream_t stream) {
    static int grid = 0;
    if (grid == 0) {
        if (n_in != 23 || in_sizes[0] != MTOK * DM || out_size != MTOK * DM || ws_size < WS_END) {
            fprintf(stderr, "kernel_launch: shape mismatch n_in %d in0 %d out %d ws %zu (need %zu)\n", n_in, n_in > 0 ? in_sizes[0] : -1, out_size, ws_size, (size_t)WS_END); grid = -1; return; }
        int dev = 0, cus = 0, per_cu = 0;
        hipGetDevice(&dev); hipDeviceGetAttribute(&cus, hipDeviceAttributeMultiprocessorCount, dev);
        if (hipFuncSetAttribute((const void*)fwd_kernel, hipFuncAttributeMaxDynamicSharedMemorySize, LDS_BYTES) != hipSuccess) { fprintf(stderr, "kernel_launch: hipFuncSetAttribute failed\n"); grid = -1; return; }
        hipOccupancyMaxActiveBlocksPerMultiprocessor(&per_cu, (const void*)fwd_kernel, 512, LDS_BYTES);
        if (per_cu < 1) { fprintf(stderr, "kernel_launch: occupancy query says %d blocks/CU\n", per_cu); per_cu = 1; }
        (void)hipGetLastError();
        grid = cus;
    }
    if (grid < 0) return;
#if MK_MULTI
    if (hipMemsetAsync((char*)d_ws + WS_BAR, 0, 256, stream) != hipSuccess) { fprintf(stderr, "kernel_launch: memset failed\n"); return; }
#endif
    Args a{};
    for (int i = 0; i < 23; ++i) a.in[i] = (const float*)d_in[i];
    a.out = (float*)d_out; a.ws = (unsigned char*)d_ws;
#if MK_MULTI
    for (int p = 0; p < NPHASE; ++p) for (int rep = 0; rep < 1 + ((MK_REP_MASK >> p) & 1); ++rep) { a.lo = p; a.hi = p + 1; hipLaunchKernelGGL(fwd_kernel, dim3(grid), dim3(512), LDS_BYTES, stream, a); }
#else
    a.lo = 0; a.hi = NPHASE;
    void* kargs[] = {&a};
    hipError_t e = hipLaunchCooperativeKernel((const void*)fwd_kernel, dim3(grid), dim3(512), kargs, LDS_BYTES, stream);
    if (e != hipSuccess) fprintf(stderr, "cooperative launch failed: %s (grid %d)\n", hipGetErrorString(e), grid);
#endif
}
```

```cpp
#include <hip/hip_runtime.h>
#include <hip/hip_cooperative_groups.h>
#include <cstdio>
#include <cstdint>
namespace cg = cooperative_groups;

#ifndef MK_REP_MASK
#define MK_REP_MASK 0
#endif
#ifndef MK_MULTI
#define MK_MULTI 0
#endif

#define LAS __attribute__((address_space(3)))
typedef unsigned short bf16_t;
typedef short bf16x8 __attribute__((ext_vector_type(8)));
typedef short s16x4 __attribute__((ext_vector_type(4)));
typedef float f32x4 __attribute__((ext_vector_type(4)));
typedef float f32x16 __attribute__((ext_vector_type(16)));
typedef unsigned u32x4 __attribute__((ext_vector_type(4)));
typedef unsigned u32x2 __attribute__((ext_vector_type(2)));

constexpr int DM = 2048, NB = 4, SEQ = 8192, CTX = 256, MTOK = NB * SEQ, SKV = SEQ + CTX, MKV = NB * SKV;
constexpr int INW = 8192, DFF = 8192, NMOD = 6 * DM;
constexpr int LDQKV = 3072, LDPG = 5120;
constexpr float EPS = 1e-6f;
constexpr int NPHASE = 10;

constexpr size_t MiB = 1u << 20;
constexpr size_t WS_MOD = 0, WS_ROPE = 256 * 1024, WS_BAR = 512 * 1024;
constexpr size_t WS_WIN = 1 * MiB, WS_WFF1 = 33 * MiB, WS_WFF2 = 65 * MiB, WS_WO = 97 * MiB, WS_WA = 105 * MiB, WS_WB = 109 * MiB, WS_WP = 113 * MiB;
constexpr size_t WS_H = 114 * MiB, WS_HC = 242 * MiB, WS_QKV = 246 * MiB, WS_PG = 444 * MiB, WS_D = 764 * MiB, WS_POOLED = 828 * MiB, WS_OSUB = 892 * MiB;
constexpr size_t WS_HEADS = WS_OSUB + 64 * MiB, WS_X1 = WS_D  , WS_M = WS_H, WS_H2 = WS_OSUB, WS_U = WS_QKV, WS_END = 1020 * MiB;
static_assert(WS_QKV + (size_t)MKV * LDQKV * 2 <= WS_PG && WS_PG + (size_t)MTOK * LDPG * 2 <= WS_D && WS_U + (size_t)MTOK * DFF * 2 <= WS_D, "ws map");

__device__ __forceinline__ unsigned cvt_pk_bf16(float lo, float hi) { unsigned r; asm volatile("v_cvt_pk_bf16_f32 %0, %1, %2" : "=v"(r) : "v"(lo), "v"(hi)); return r; }
__device__ __forceinline__ float bflo(unsigned w) { return __uint_as_float(w << 16); }
__device__ __forceinline__ float bfhi(unsigned w) { return __uint_as_float(w & 0xffff0000u); }
__device__ __forceinline__ float wave_sum(float v) {
#pragma unroll
    for (int o = 1; o < 64; o <<= 1) v += __shfl_xor(v, o);
    return v;
}
__device__ __forceinline__ float sigmoidf_(float v) { return __builtin_amdgcn_rcpf(1.0f + __builtin_amdgcn_exp2f(-1.4426950408889634f * v)); }

__device__ __forceinline__ int lane_id_opaque() { unsigned m = ~0u; asm volatile("" : "+s"(m)); return (int)__builtin_amdgcn_mbcnt_hi(m, __builtin_amdgcn_mbcnt_lo(m, 0u)); }

namespace pg8 {
constexpr int BM = 256, BK = 64, HALF = 128, HTB = HALF * BK * 2, STAGE_BYTES = 8 * HTB, NXCD = 8, WGM = 8;
__host__ __device__ __forceinline__ int lds_byte(int r, int c) { const int st = (r >> 4) * 2 + (c >> 5), rr = r & 15, cc = c & 31, ob = rr * 64 + cc * 2; return st * 1024 + (ob ^ (((ob >> 9) & 1) << 5)); }
__host__ __device__ __forceinline__ void stage_rc(int b, int& R, int& C) { const int st = b / 1024, sb = b % 1024, swz = sb ^ (((sb >> 9) & 1) << 5); R = (st >> 1) * 16 + swz / 64; C = (st & 1) * 32 + (swz % 64) / 2; }
__host__ __device__ __forceinline__ int perm32(int rho) { const int n = rho >> 4, i = rho & 15; return 8 * (i >> 2) + 4 * n + (i & 3); }

struct Unit { int pm, pn; };
struct Gemm { const bf16_t* A; const bf16_t* Bt; int M, N, K, lda, ldb, akoff; size_t ksa, ksb; };

struct StaticOrder {
    int nM, nN, nwg, G, c;
    __device__ void init(int M, int N, int G_, int c_) { nM = M / BM; nN = N / BM; nwg = nM * nN; G = G_; c = c_; }
    __device__ bool next(int i, Unit& u) const {
        const long L = (long)i * G + c; if (L >= nwg) return false;
        int wgid = (int)L; { const int q = nwg / NXCD, r = nwg % NXCD, xcd = wgid % NXCD, off = wgid / NXCD; wgid = (xcd < r ? xcd * (q + 1) : r * (q + 1) + (xcd - r) * q) + off; }
        const int nig = WGM * nN, gid = wgid / nig, fm = gid * WGM, gsz = (nM - fm) < WGM ? (nM - fm) : WGM;
        u.pm = fm + ((wgid % nig) % gsz); u.pn = (wgid % nig) / gsz; return true;
    }
};

enum { E_G1 = 0, E_CTX, E_POOL, E_YA, E_YB, E_WO, E_FF1, E_FF2 };
template <int MODE> struct Epi {
    bf16_t* o16; bf16_t* o16b; float* o32; const float* x32; const float* vec; const bf16_t* g16;
    static __device__ __forceinline__ u32x4 pack8(const f32x4& v0, const f32x4& v1) { u32x4 w; w.x = cvt_pk_bf16(v0[0], v0[1]); w.y = cvt_pk_bf16(v0[2], v0[3]); w.z = cvt_pk_bf16(v1[0], v1[1]); w.w = cvt_pk_bf16(v1[2], v1[3]); return w; }
    static __device__ __forceinline__ void mul8(f32x4& v0, f32x4& v1, const u32x4& g) { v0[0] *= bflo(g.x); v0[1] *= bfhi(g.x); v0[2] *= bflo(g.y); v0[3] *= bfhi(g.y); v1[0] *= bflo(g.z); v1[1] *= bfhi(g.z); v1[2] *= bflo(g.w); v1[3] *= bfhi(g.w); }
    static __device__ __forceinline__ void add8(f32x4& v0, f32x4& v1, const u32x4& a) { v0[0] += bflo(a.x); v0[1] += bfhi(a.x); v0[2] += bflo(a.y); v0[3] += bfhi(a.y); v1[0] += bflo(a.z); v1[1] += bfhi(a.z); v1[2] += bflo(a.w); v1[3] += bfhi(a.w); }
    __device__ __forceinline__ void operator()(const f32x4 (&acc)[2][2][4][2], const Unit& u, int wr, int wc, int fr, int fq) const {
        const int rowt = u.pm * BM + wr * 64 + fr, colt = u.pn * BM + wc * 32 + 8 * fq;
        if constexpr (MODE == E_WO || MODE == E_FF2) {
            const float* gv = vec + (size_t)(rowt >> 13) * NMOD + colt;
            f32x4 g[2][2];
#pragma unroll
            for (int bj = 0; bj < 2; ++bj) { g[bj][0] = *(const f32x4*)(gv + bj * HALF); g[bj][1] = *(const f32x4*)(gv + bj * HALF + 4); }
#pragma unroll
            for (int ai = 0; ai < 2; ++ai) {
                if constexpr (MODE == E_WO) {
                    f32x4 xb[4][2][2];
#pragma unroll
                    for (int m = 0; m < 4; ++m)
#pragma unroll
                        for (int bj = 0; bj < 2; ++bj) { const size_t off = (size_t)(rowt + ai * HALF + m * 16) * DM + colt + bj * HALF;
                            xb[m][bj][0] = __builtin_nontemporal_load((const f32x4*)(x32 + off)); xb[m][bj][1] = __builtin_nontemporal_load((const f32x4*)(x32 + off + 4)); }
#pragma unroll
                    for (int m = 0; m < 4; ++m)
#pragma unroll
                        for (int bj = 0; bj < 2; ++bj) { const size_t off = (size_t)(rowt + ai * HALF + m * 16) * DM + colt + bj * HALF;
                            *(u32x4*)(o16 + off) = pack8(xb[m][bj][0] + g[bj][0] * acc[ai][bj][m][0], xb[m][bj][1] + g[bj][1] * acc[ai][bj][m][1]); }
                } else {
                    u32x4 xb[4][2];
#pragma unroll
                    for (int m = 0; m < 4; ++m)
#pragma unroll
                        for (int bj = 0; bj < 2; ++bj) xb[m][bj] = *(const u32x4*)(g16 + (size_t)(rowt + ai * HALF + m * 16) * DM + colt + bj * HALF);
#pragma unroll
                    for (int m = 0; m < 4; ++m)
#pragma unroll
                        for (int bj = 0; bj < 2; ++bj) { const size_t off = (size_t)(rowt + ai * HALF + m * 16) * DM + colt + bj * HALF;
                            f32x4 v0 = g[bj][0] * acc[ai][bj][m][0], v1 = g[bj][1] * acc[ai][bj][m][1];
                            add8(v0, v1, xb[m][bj]);
                            *(f32x4*)(o32 + off) = v0; *(f32x4*)(o32 + off + 4) = v1; }
                }
            }
        } else if constexpr (MODE == E_YA || MODE == E_YB) {
#pragma unroll
            for (int ai = 0; ai < 2; ++ai) {
                u32x4 gb[4][2], mb[4][2];
#pragma unroll
                for (int m = 0; m < 4; ++m)
#pragma unroll
                    for (int bj = 0; bj < 2; ++bj) { const int row = rowt + ai * HALF + m * 16, col = colt + bj * HALF;
                        gb[m][bj] = *(const u32x4*)(g16 + (size_t)row * LDPG + 1024 + (MODE == E_YB ? DM : 0) + col);
                        if constexpr (MODE == E_YB) mb[m][bj] = *(const u32x4*)(o16 + (size_t)row * DM + col); }
#pragma unroll
                for (int m = 0; m < 4; ++m)
#pragma unroll
                    for (int bj = 0; bj < 2; ++bj) { const int row = rowt + ai * HALF + m * 16, col = colt + bj * HALF;
                        f32x4 v0 = acc[ai][bj][m][0], v1 = acc[ai][bj][m][1];
                        mul8(v0, v1, gb[m][bj]);
                        if constexpr (MODE == E_YB) add8(v0, v1, mb[m][bj]);
                        *(u32x4*)(o16 + (size_t)row * DM + col) = pack8(v0, v1); }
            }
        } else {
#pragma unroll
        for (int ai = 0; ai < 2; ++ai)
#pragma unroll
            for (int m = 0; m < 4; ++m) {
                const int row = rowt + ai * HALF + m * 16;
#pragma unroll
                for (int bj = 0; bj < 2; ++bj) {
                    const int col = colt + bj * HALF;
                    f32x4 v0 = acc[ai][bj][m][0], v1 = acc[ai][bj][m][1];
                    if constexpr (MODE == E_G1) {
                        bf16_t* p;
                        if (u.pn < 12) { p = o16 + (size_t)(row + (row >> 13) * CTX) * LDQKV + col; }
                        else { p = o16b + (size_t)row * LDPG + (col - 3072);
                            if (u.pn >= 16) {
#pragma unroll
                                for (int j = 0; j < 4; ++j) { v0[j] = sigmoidf_(v0[j]); v1[j] = sigmoidf_(v1[j]); } } }
                        *(u32x4*)p = pack8(v0, v1);
                    } else if constexpr (MODE == E_CTX) {
                        *(u32x4*)(o16 + (size_t)(u.pm * SKV + SEQ + (row - u.pm * BM)) * LDQKV + 1024 + col) = pack8(v0, v1);
                    } else if constexpr (MODE == E_POOL) {
                        const f32x4 s0 = *(const f32x4*)(vec + col), s1 = *(const f32x4*)(vec + col + 4);
                        v0 = v0 * s0; v1 = v1 * s1;
                        *(u32x4*)(o16 + (size_t)row * 1024 + col) = pack8(v0, v1);
                    } else if constexpr (MODE == E_FF1) {
#pragma unroll
                        for (int j = 0; j < 4; ++j) { const float a = fmaxf(v0[j], 0.f), b = fmaxf(v1[j], 0.f); v0[j] = a * a; v1[j] = b * b; }
                        __builtin_nontemporal_store(pack8(v0, v1), (u32x4*)(o16 + (size_t)(col >> 6) * ((size_t)MTOK * 64) + (size_t)row * 64 + (col & 63)));
                    }
                }
            }
        }
    }
};

template <class EpiT>
__device__ __forceinline__ void gemm_phase(const int tid, LAS unsigned char* lds, const Gemm g, const StaticOrder& S, const EpiT& E) {
    const int wid = __builtin_amdgcn_readfirstlane(tid >> 6), lane = tid & 63, wr = wid >> 2, wc = wid & 3, fr = lane & 15, fq = lane >> 4;
    const int K = g.K, nt = K / BK;
    unsigned voffA[2], voffB[2];
#pragma unroll
    for (int i = 0; i < 2; ++i) { int R, C; stage_rc(tid * 16 + i * 8192, R, C); const int Rb = (R & ~31) + perm32(R & 31);
        voffA[i] = (unsigned)(R * g.lda + C) * 2u; voffB[i] = (unsigned)(Rb * g.ldb + C) * 2u; }
    const size_t kstepA = g.ksa, kstepB = g.ksb;
    const size_t hstepA = (size_t)HALF * g.lda * 2, hstepB = (size_t)HALF * g.ldb * 2;
    const size_t tstepA = 2 * hstepA, tstepB = 2 * hstepB;
    const unsigned ldsw = (unsigned)wid * 1024u;
    const int aoff = lds_byte(wr * 64 + fr, fq * 8), boff = lds_byte(wc * 32 + fr, fq * 8);
#define PG8_SA(b, h) (((b) * 2 + (h)) * HTB)
#define PG8_SB(b, h) ((4 + (b) * 2 + (h)) * HTB)
#define PG8_STAGE(bufoff, gbase, voff) do { _Pragma("unroll") for (int _i = 0; _i < 2; ++_i) \
        __builtin_amdgcn_global_load_lds((const unsigned*)((const char*)(gbase) + (voff)[_i]), (LAS unsigned*)(lds + (bufoff) + ldsw + _i * 8192), 16, 0, 0); } while (0)
#define PG8_LDA(dst, b, h) do { _Pragma("unroll") for (int m = 0; m < 4; ++m) _Pragma("unroll") for (int k = 0; k < 2; ++k) dst[m][k] = *(const LAS bf16x8*)(lds + PG8_SA(b, h) + aoff + m * 2048 + k * 1024); } while (0)
#define PG8_LDB(dst, b, h) do { _Pragma("unroll") for (int n = 0; n < 2; ++n) _Pragma("unroll") for (int k = 0; k < 2; ++k) dst[n][k] = *(const LAS bf16x8*)(lds + PG8_SB(b, h) + boff + n * 2048 + k * 1024); } while (0)
#define PG8_MMA(ai, bj, At, Bt) do { __builtin_amdgcn_s_setprio(1); _Pragma("unroll") for (int m = 0; m < 4; ++m) _Pragma("unroll") for (int n = 0; n < 2; ++n) _Pragma("unroll") for (int k = 0; k < 2; ++k) \
        acc[ai][bj][m][n] = __builtin_amdgcn_mfma_f32_16x16x32_bf16(Bt[n][k], At[m][k], acc[ai][bj][m][n], 0, 0, 0); __builtin_amdgcn_s_setprio(0); } while (0)
#define PG8_WAIT_V(n) asm volatile("s_waitcnt vmcnt(" #n ")" ::: "memory")
#define PG8_WAIT_L(n) asm volatile("s_waitcnt lgkmcnt(" #n ")" ::: "memory")
#define PG8_BAR __builtin_amdgcn_s_barrier()
#define PG8_SCHED __builtin_amdgcn_sched_barrier(0)
    Unit cur, nxt; int ui = 0;
    if (!S.next(0, cur)) return;
    f32x4 acc[2][2][4][2];
#pragma unroll
    for (int a = 0; a < 2; ++a)
#pragma unroll
        for (int b = 0; b < 2; ++b)
#pragma unroll
            for (int m = 0; m < 4; ++m)
#pragma unroll
                for (int n = 0; n < 2; ++n) acc[a][b][m][n] = (f32x4){0.f, 0.f, 0.f, 0.f};
    bf16x8 At[4][2], B0[2][2], B1[2][2];
    const char* cA = (const char*)g.A + (size_t)cur.pm * tstepA + (size_t)cur.pn * g.akoff * 2; const char* cB = (const char*)g.Bt + (size_t)cur.pn * tstepB;
    PG8_STAGE(PG8_SB(0, 0), cB, voffB); PG8_STAGE(PG8_SB(0, 1), cB + hstepB, voffB); PG8_STAGE(PG8_SA(0, 0), cA, voffA); PG8_STAGE(PG8_SA(0, 1), cA + hstepA, voffA);
    if (wr == 1) PG8_BAR;
    PG8_WAIT_V(2); PG8_BAR;
    PG8_STAGE(PG8_SB(1, 0), cB + kstepB, voffB); PG8_STAGE(PG8_SA(1, 0), cA + kstepA, voffA); PG8_STAGE(PG8_SB(1, 1), cB + hstepB + kstepB, voffB);
    PG8_WAIT_V(6); PG8_BAR;
    for (;;) {
        const bool has_next = S.next(ui + 1, nxt);
        const char* nA = has_next ? (const char*)g.A + (size_t)nxt.pm * tstepA + (size_t)nxt.pn * g.akoff * 2 : cA; const char* nB = has_next ? (const char*)g.Bt + (size_t)nxt.pn * tstepB : cB;
        for (int t = 0; t < nt; t += 2) {
            const bool last = (t == nt - 2);
            const char* a1 = cA + (size_t)(t + 1) * kstepA;
            const char* a2 = last ? nA : cA + (size_t)(t + 2) * kstepA; const char* b2 = last ? nB : cB + (size_t)(t + 2) * kstepB;
            const char* a3 = a2 + kstepA; const char* b3 = b2 + kstepB;
            PG8_LDB(B0, 0, 0); PG8_LDB(B1, 0, 1); PG8_SCHED; PG8_LDA(At, 0, 0); PG8_STAGE(PG8_SA(1, 1), a1 + hstepA, voffA);
            PG8_WAIT_V(8); PG8_WAIT_L(0); PG8_BAR; PG8_MMA(0, 0, At, B0); PG8_MMA(0, 1, At, B1); PG8_BAR; PG8_SCHED;
            PG8_LDA(At, 0, 1); PG8_STAGE(PG8_SB(0, 0), b2, voffB); PG8_STAGE(PG8_SB(0, 1), b2 + hstepB, voffB); PG8_STAGE(PG8_SA(0, 0), a2, voffA);
            PG8_WAIT_V(8); PG8_WAIT_L(0); PG8_BAR; PG8_MMA(1, 0, At, B0); PG8_MMA(1, 1, At, B1); PG8_BAR; PG8_SCHED;
            PG8_LDB(B0, 1, 0); PG8_LDB(B1, 1, 1); PG8_SCHED; PG8_LDA(At, 1, 0); PG8_STAGE(PG8_SA(0, 1), a2 + hstepA, voffA);
            PG8_WAIT_V(8); PG8_WAIT_L(0); PG8_BAR; PG8_MMA(0, 0, At, B0); PG8_MMA(0, 1, At, B1); PG8_BAR; PG8_SCHED;
            PG8_LDA(At, 1, 1); PG8_STAGE(PG8_SB(1, 0), b3, voffB); PG8_STAGE(PG8_SB(1, 1), b3 + hstepB, voffB); PG8_STAGE(PG8_SA(1, 0), a3, voffA);
            PG8_WAIT_V(8); PG8_WAIT_L(0); PG8_BAR; PG8_MMA(1, 0, At, B0); PG8_MMA(1, 1, At, B1); PG8_BAR; PG8_SCHED;
        }
        if (wr == 0) PG8_BAR;
        E(acc, cur, wr, wc, fr, fq);
        if (!has_next) break;
#pragma unroll
        for (int a = 0; a < 2; ++a)
#pragma unroll
            for (int b = 0; b < 2; ++b)
#pragma unroll
                for (int m = 0; m < 4; ++m)
#pragma unroll
                    for (int n = 0; n < 2; ++n) acc[a][b][m][n] = (f32x4){0.f, 0.f, 0.f, 0.f};
        cur = nxt; cA = nA; cB = nB; ++ui;
        if (wr == 1) PG8_BAR;
    }
    PG8_WAIT_V(0);
    PG8_BAR;
#undef PG8_SA
#undef PG8_SB
#undef PG8_STAGE
#undef PG8_LDA
#undef PG8_LDB
#undef PG8_MMA
#undef PG8_WAIT_V
#undef PG8_WAIT_L
#undef PG8_BAR
#undef PG8_SCHED
}
}

namespace att {
constexpr int NW = 8, QBLK = 32, KVBLK = 64;
constexpr float QSCALE = 0.125f * 1.4426950408889634f;
constexpr int SHM_V = KVBLK * 128 * 2, SHM_K = KVBLK * 64 * 2, NBUF = 4;
#define KSWZ64(row, colB) ((row) * 128 + ((colB) ^ ((((row) >> 1) & 7) << 4)))
#define SBAR() __builtin_amdgcn_sched_barrier(0)
__device__ __forceinline__ int crow(int r, int hi) { return (r & 3) + 8 * (r >> 2) + 4 * hi; }
#define PK4(P, BASE, OUT) do { unsigned a0 = cvt_pk_bf16(P[BASE + 0], P[BASE + 1]), a1 = cvt_pk_bf16(P[BASE + 2], P[BASE + 3]);   \
    unsigned b0 = cvt_pk_bf16(P[BASE + 4], P[BASE + 5]), b1 = cvt_pk_bf16(P[BASE + 6], P[BASE + 7]);                              \
    auto r0 = __builtin_amdgcn_permlane32_swap(a0, b0, false, false); auto r1 = __builtin_amdgcn_permlane32_swap(a1, b1, false, false); \
    u32x4 w = {r0[0], r1[0], r0[1], r1[1]}; OUT = *reinterpret_cast<bf16x8*>(&w); } while (0)
__device__ __forceinline__ void partialSM(f32x16& p0, float& l_reg, bf16x8& pa0, bf16x8& pa1) {
#pragma unroll
    for (int r = 0; r < 16; ++r) p0[r] = __builtin_amdgcn_exp2f(p0[r]);
    float ps = 0;
#pragma unroll
    for (int r = 0; r < 16; ++r) ps += p0[r];
    l_reg += ps;
    PK4(p0, 0, pa0); PK4(p0, 8, pa1);
}
__device__ __forceinline__ void finishSM(f32x16& p1, float& l_reg, bf16x8& pa2, bf16x8& pa3) {
#pragma unroll
    for (int r = 0; r < 16; ++r) p1[r] = __builtin_amdgcn_exp2f(p1[r]);
    float ps = 0;
#pragma unroll
    for (int r = 0; r < 16; ++r) ps += p1[r];
    l_reg += ps;
    PK4(p1, 0, pa2); PK4(p1, 8, pa3);
}
#undef PK4
__device__ __forceinline__ void qkt(f32x16& p0, f32x16& p1, const char* Ks, const bf16x8* qr, const f32x16& negm, int r32, int hi) {
#pragma unroll
    for (int d0 = 0; d0 < 4; ++d0) { const int cb = d0 * 32 + hi * 16;
        bf16x8 b0 = *reinterpret_cast<const bf16x8*>(Ks + KSWZ64(r32, cb));
        bf16x8 b1 = *reinterpret_cast<const bf16x8*>(Ks + KSWZ64(32 + r32, cb));
        if (d0 == 0) { p0 = __builtin_amdgcn_mfma_f32_32x32x16_bf16(b0, qr[0], negm, 0, 0, 0); p1 = __builtin_amdgcn_mfma_f32_32x32x16_bf16(b1, qr[0], negm, 0, 0, 0); }
        else { p0 = __builtin_amdgcn_mfma_f32_32x32x16_bf16(b0, qr[d0], p0, 0, 0, 0); p1 = __builtin_amdgcn_mfma_f32_32x32x16_bf16(b1, qr[d0], p1, 0, 0, 0); } }
}
__device__ __forceinline__ int v_st(int k, int c) { const int kk = (k & ~0xC) | ((k & 4) << 1) | ((k & 8) >> 1); return ((kk >> 3) * 4 + (c >> 5)) * 512 + ((kk & 7) * 32 + (c & 31)) * 2; }
__device__ __forceinline__ int v_rd_base(int lane) { return ((lane & 3) << 3) | (((lane >> 2) & 3) << 6) | (((lane >> 4) & 1) << 5) | (((lane >> 5) & 1) << 8); }
constexpr int v_rd_off(int d0, int ks, int half) { return d0 * 512 + ks * 4096 + half * 2048; }
template <int OFF> __device__ __forceinline__ s16x4 tr_read(int vb) {
    s16x4 r; asm volatile("ds_read_b64_tr_b16 %0, %1 offset:%2" : "=&v"(r) : "v"(vb), "i"(OFF) : "memory"); return r;
}
template <int D0> __device__ __forceinline__ void pv_one(f32x16& od, int vb, bf16x8 pa0, bf16x8 pa1, bf16x8 pa2, bf16x8 pa3) {
    const s16x4 l0 = tr_read<v_rd_off(D0, 0, 0)>(vb), h0 = tr_read<v_rd_off(D0, 0, 1)>(vb), l1 = tr_read<v_rd_off(D0, 1, 0)>(vb), h1 = tr_read<v_rd_off(D0, 1, 1)>(vb);
    const s16x4 l2 = tr_read<v_rd_off(D0, 2, 0)>(vb), h2 = tr_read<v_rd_off(D0, 2, 1)>(vb), l3 = tr_read<v_rd_off(D0, 3, 0)>(vb), h3 = tr_read<v_rd_off(D0, 3, 1)>(vb);
    asm volatile("s_waitcnt lgkmcnt(0)" ::: "memory"); SBAR();
#define PK(L, H) (bf16x8){L[0], L[1], L[2], L[3], H[0], H[1], H[2], H[3]}
    od = __builtin_amdgcn_mfma_f32_32x32x16_bf16(pa0, PK(l0, h0), od, 0, 0, 0);
    od = __builtin_amdgcn_mfma_f32_32x32x16_bf16(pa1, PK(l1, h1), od, 0, 0, 0);
    od = __builtin_amdgcn_mfma_f32_32x32x16_bf16(pa2, PK(l2, h2), od, 0, 0, 0);
    od = __builtin_amdgcn_mfma_f32_32x32x16_bf16(pa3, PK(l3, h3), od, 0, 0, 0);
#undef PK
}
__device__ __forceinline__ void pv_d0(f32x16* o, int vb, bf16x8 pa0, bf16x8 pa1, bf16x8 pa2, bf16x8 pa3) {
    pv_one<0>(o[0], vb, pa0, pa1, pa2, pa3); pv_one<1>(o[1], vb, pa0, pa1, pa2, pa3); pv_one<2>(o[2], vb, pa0, pa1, pa2, pa3); pv_one<3>(o[3], vb, pa0, pa1, pa2, pa3);
}
#define PKF(L, H) (bf16x8){L[0], L[1], L[2], L[3], H[0], H[1], H[2], H[3]}
template <int I, bool EXPS> __device__ __forceinline__ void pv_roll_step(f32x16* o, int vb, const bf16x8& pa0, const bf16x8& pa1, const bf16x8& pa2, const bf16x8& pa3, s16x4 (&L)[4], s16x4 (&H)[4], f32x16& c0, float& ps, unsigned (&cv)[4], bf16x8& ca0) {
    constexpr int ks = I >> 2, d0 = I & 3, sl = I & 3, rem = 15 - I, n = 2 * (rem < 3 ? rem : 3);
    asm volatile("s_waitcnt lgkmcnt(%0)" :: "n"(n) : "memory"); SBAR();
    o[d0] = __builtin_amdgcn_mfma_f32_32x32x16_bf16(ks == 0 ? pa0 : ks == 1 ? pa1 : ks == 2 ? pa2 : pa3, PKF(L[sl], H[sl]), o[d0], 0, 0, 0);
    if constexpr (EXPS) { c0[I] = __builtin_amdgcn_exp2f(c0[I]); if constexpr (I >= 1) ps += c0[I - 1];
        if constexpr (I == 9) { cv[0] = cvt_pk_bf16(c0[0], c0[1]); cv[1] = cvt_pk_bf16(c0[2], c0[3]); cv[2] = cvt_pk_bf16(c0[4], c0[5]); cv[3] = cvt_pk_bf16(c0[6], c0[7]); }
        if constexpr (I == 10) { auto r0 = __builtin_amdgcn_permlane32_swap(cv[0], cv[2], false, false); auto r1 = __builtin_amdgcn_permlane32_swap(cv[1], cv[3], false, false);
            u32x4 w = {r0[0], r1[0], r0[1], r1[1]}; ca0 = *reinterpret_cast<bf16x8*>(&w); } }
    if constexpr (I + 4 < 16) { SBAR(); L[sl] = tr_read<v_rd_off((I + 4) & 3, (I + 4) >> 2, 0)>(vb); H[sl] = tr_read<v_rd_off((I + 4) & 3, (I + 4) >> 2, 1)>(vb); }
}
__device__ __forceinline__ void pv_window0(int vb, s16x4 (&L)[4], s16x4 (&H)[4]) {
    L[0] = tr_read<v_rd_off(0, 0, 0)>(vb); H[0] = tr_read<v_rd_off(0, 0, 1)>(vb); L[1] = tr_read<v_rd_off(1, 0, 0)>(vb); H[1] = tr_read<v_rd_off(1, 0, 1)>(vb);
    L[2] = tr_read<v_rd_off(2, 0, 0)>(vb); H[2] = tr_read<v_rd_off(2, 0, 1)>(vb); L[3] = tr_read<v_rd_off(3, 0, 0)>(vb); H[3] = tr_read<v_rd_off(3, 0, 1)>(vb);
}
template <bool EXPS> __device__ __forceinline__ void pv_roll(f32x16* o, int vb, const bf16x8& pa0, const bf16x8& pa1, const bf16x8& pa2, const bf16x8& pa3, s16x4 (&L)[4], s16x4 (&H)[4], f32x16& c0, float& l_reg, bf16x8& ca0, bf16x8& ca1) {
    float ps = 0.f; unsigned cv[4] = {0u, 0u, 0u, 0u};
    pv_roll_step<0, EXPS>(o, vb, pa0, pa1, pa2, pa3, L, H, c0, ps, cv, ca0);   pv_roll_step<1, EXPS>(o, vb, pa0, pa1, pa2, pa3, L, H, c0, ps, cv, ca0);   pv_roll_step<2, EXPS>(o, vb, pa0, pa1, pa2, pa3, L, H, c0, ps, cv, ca0);   pv_roll_step<3, EXPS>(o, vb, pa0, pa1, pa2, pa3, L, H, c0, ps, cv, ca0);
    pv_roll_step<4, EXPS>(o, vb, pa0, pa1, pa2, pa3, L, H, c0, ps, cv, ca0);   pv_roll_step<5, EXPS>(o, vb, pa0, pa1, pa2, pa3, L, H, c0, ps, cv, ca0);   pv_roll_step<6, EXPS>(o, vb, pa0, pa1, pa2, pa3, L, H, c0, ps, cv, ca0);   pv_roll_step<7, EXPS>(o, vb, pa0, pa1, pa2, pa3, L, H, c0, ps, cv, ca0);
    pv_roll_step<8, EXPS>(o, vb, pa0, pa1, pa2, pa3, L, H, c0, ps, cv, ca0);   pv_roll_step<9, EXPS>(o, vb, pa0, pa1, pa2, pa3, L, H, c0, ps, cv, ca0);   pv_roll_step<10, EXPS>(o, vb, pa0, pa1, pa2, pa3, L, H, c0, ps, cv, ca0);  pv_roll_step<11, EXPS>(o, vb, pa0, pa1, pa2, pa3, L, H, c0, ps, cv, ca0);
    pv_roll_step<12, EXPS>(o, vb, pa0, pa1, pa2, pa3, L, H, c0, ps, cv, ca0);  pv_roll_step<13, EXPS>(o, vb, pa0, pa1, pa2, pa3, L, H, c0, ps, cv, ca0);  pv_roll_step<14, EXPS>(o, vb, pa0, pa1, pa2, pa3, L, H, c0, ps, cv, ca0);  pv_roll_step<15, EXPS>(o, vb, pa0, pa1, pa2, pa3, L, H, c0, ps, cv, ca0);
    SBAR();
    if constexpr (EXPS) { ps += c0[15]; l_reg += ps;
        unsigned a0 = cvt_pk_bf16(c0[8], c0[9]), a1 = cvt_pk_bf16(c0[10], c0[11]), b0 = cvt_pk_bf16(c0[12], c0[13]), b1 = cvt_pk_bf16(c0[14], c0[15]);
        auto r0 = __builtin_amdgcn_permlane32_swap(a0, b0, false, false); auto r1 = __builtin_amdgcn_permlane32_swap(a1, b1, false, false);
        u32x4 w = {r0[0], r1[0], r0[1], r1[1]}; ca1 = *reinterpret_cast<bf16x8*>(&w); }
}
__device__ __forceinline__ void partialSM_tail(f32x16& p0, float& l_reg, bf16x8& pa0, bf16x8& pa1) {
    float ps = 0;
#pragma unroll
    for (int r = 0; r < 16; ++r) ps += p0[r];
    l_reg += ps;
#define PK4(P, BASE, OUT) do { unsigned a0 = cvt_pk_bf16(P[BASE + 0], P[BASE + 1]), a1 = cvt_pk_bf16(P[BASE + 2], P[BASE + 3]);   \
    unsigned b0 = cvt_pk_bf16(P[BASE + 4], P[BASE + 5]), b1 = cvt_pk_bf16(P[BASE + 6], P[BASE + 7]);                              \
    auto r0 = __builtin_amdgcn_permlane32_swap(a0, b0, false, false); auto r1 = __builtin_amdgcn_permlane32_swap(a1, b1, false, false); \
    u32x4 w = {r0[0], r1[0], r0[1], r1[1]}; OUT = *reinterpret_cast<bf16x8*>(&w); } while (0)
    PK4(p0, 0, pa0); PK4(p0, 8, pa1);
#undef PK4
}
#undef PKF
template <bool SECOND>
__device__ __forceinline__ void attn_unit(const bf16_t* __restrict__ Qb, const bf16_t* __restrict__ Kh, const bf16_t* __restrict__ Vh, bf16_t* O1, bf16_t* Hd, float lam, const float* subln, int seq, float KN, char* lds, LAS unsigned char* ldsl, const int wave_s) {
    int tid = wave_s * 64 + lane_id_opaque(); asm volatile("" : "+v"(tid));
    const int wid = __builtin_amdgcn_readfirstlane(tid >> 6), lane = tid & 63, r32 = lane & 31, hi = lane >> 5;
    constexpr int KOFF = NBUF * SHM_V;
    char* V_lds = lds; char* K_lds = lds + KOFF;
    float* ws = (float*)(lds + NBUF * SHM_V + NBUF * SHM_K) + wid * 64; float* li_l = ws;
    float l_reg = 0; f32x16 o[4] = {}; bf16x8 qr[4];
    const bf16_t* Qw = Qb + (long)(wid * QBLK + r32) * LDQKV + hi * 8;
#pragma unroll
    for (int d0 = 0; d0 < 4; ++d0) qr[d0] = *reinterpret_cast<const bf16x8*>(Qw + d0 * 16);
    unsigned kgo, vgo0, vgo1;
    { const int row = wid * 8 + (lane >> 3), colB = ((lane & 7) * 16) ^ (((row >> 1) & 7) << 4);
      kgo = (unsigned)(row * LDQKV * 2 + colB);
      const int st0 = wid * 2 + (lane >> 5), st1 = 16 + st0, klo = (lane & 31) >> 2, cl = (lane & 3) * 8;
      const int kk0 = (st0 >> 2) * 8 + klo, kk1 = (st1 >> 2) * 8 + klo;
      const int k0 = (kk0 & ~0xC) | ((kk0 & 4) << 1) | ((kk0 & 8) >> 1), k1 = (kk1 & ~0xC) | ((kk1 & 4) << 1) | ((kk1 & 8) >> 1);
      const unsigned dv = (unsigned)((const char*)Vh - (const char*)Kh);
      vgo0 = dv + (unsigned)((k0 * LDQKV + (st0 & 3) * 32 + cl) * 2); vgo1 = dv + (unsigned)((k1 * LDQKV + (st1 & 3) * 32 + cl) * 2); }
#define DMA(t, slot) do { const char* gb_ = (const char*)Kh + (size_t)(t) * (KVBLK * LDQKV * 2); \
    __builtin_amdgcn_global_load_lds((const unsigned*)(gb_ + kgo), (LAS unsigned*)(ldsl + KOFF + (slot) * SHM_K + wid * 1024), 16, 0, 0); \
    __builtin_amdgcn_global_load_lds((const unsigned*)(gb_ + vgo0), (LAS unsigned*)(ldsl + (slot) * SHM_V + wid * 1024), 16, 0, 0); \
    __builtin_amdgcn_global_load_lds((const unsigned*)(gb_ + vgo1), (LAS unsigned*)(ldsl + (slot) * SHM_V + 8192 + wid * 1024), 16, 0, 0); } while (0)
#define WAIT_BAR(N) asm volatile("s_waitcnt vmcnt(" #N ") lgkmcnt(0)\n\ts_barrier" ::: "memory")
    DMA(0, 0); DMA(1, 1);
    f32x16 negm;
    { float ss = 0.f;
#pragma unroll
      for (int d0 = 0; d0 < 4; ++d0)
#pragma unroll
          for (int e = 0; e < 8; ++e) { const float v = __uint_as_float(((unsigned)(unsigned short)qr[d0][e]) << 16); ss += v * v; }
      auto rr = __builtin_amdgcn_permlane32_swap(__float_as_uint(ss), __float_as_uint(ss), false, false);
      ss = __uint_as_float(rr[0]) + __uint_as_float(rr[1]);
      const float nb = -sqrtf(ss) * KN;
#pragma unroll
      for (int r = 0; r < 16; ++r) negm[r] = nb; }
    const int vb0 = (int)(uintptr_t)V_lds + v_rd_base(lane);
    f32x16 pA0, pA1, pB0, pB1; bf16x8 paA0, paA1, paB0, paB1, pa2, pa3; const int NT = seq / KVBLK;
    const bool grpB = false;
    WAIT_BAR(3);
    DMA(2, 2);
    qkt(pA0, pA1, K_lds, qr, negm, r32, hi); partialSM(pA0, l_reg, paA0, paA1);
    WAIT_BAR(3);
    if (grpB) WAIT_BAR(3);
#define STEP(j, C0, C1, CA0, CA1, P1, PA0, PA1) do { \
        if ((j) + 2 < NT) DMA((j) + 2, ((j) + 2) & 3); \
        const int vb_ = vb0 + (((j) - 1) & 3) * SHM_V; \
        SBAR(); pv_window0(vb_, VL, VH); SBAR(); \
        qkt(C0, C1, K_lds + ((j) & 3) * SHM_K, qr, negm, r32, hi); \
        finishSM(P1, l_reg, pa2, pa3); SBAR(); \
        pv_roll<true>(o, vb_, PA0, PA1, pa2, pa3, VL, VH, C0, l_reg, CA0, CA1); SBAR(); \
        if ((j) + 2 < NT) WAIT_BAR(3); else WAIT_BAR(0); } while (0)
    s16x4 VL[4], VH[4];
    for (int j = 1; j + 1 < NT; j += 2) {
        STEP(j, pB0, pB1, paB0, paB1, pA1, paA0, paA1);
        STEP(j + 1, pA0, pA1, paA0, paA1, pB1, paB0, paB1);
    }
    STEP(NT - 1, pB0, pB1, paB0, paB1, pA1, paA0, paA1);
    finishSM(pB1, l_reg, pa2, pa3); SBAR();
    pv_window0(vb0 + ((NT - 1) & 3) * SHM_V, VL, VH);
    pv_roll<false>(o, vb0 + ((NT - 1) & 3) * SHM_V, paB0, paB1, pa2, pa3, VL, VH, pB0, l_reg, paB0, paB1);
    if (!grpB) WAIT_BAR(0);
#undef STEP
    { auto rr = __builtin_amdgcn_permlane32_swap(__float_as_uint(l_reg), __float_as_uint(l_reg), false, false); l_reg = __uint_as_float(rr[0]) + __uint_as_float(rr[1]); }
    if (hi == 0) li_l[r32] = l_reg; asm volatile("s_waitcnt lgkmcnt(0)" ::: "memory");
    float rli[16];
#pragma unroll
    for (int r = 0; r < 16; ++r) rli[r] = __builtin_amdgcn_rcpf(li_l[crow(r, hi)]);
#define ROWWALK(PTR, r) do { PTR += ((r) & 3) == 3 ? 5 * 1024 : 1024; asm volatile("" : "+v"(PTR)); } while (0)
    const long lane_off = (long)(wid * QBLK + 4 * hi) * 1024 + r32;
    if constexpr (!SECOND) {
        bf16_t* pw = O1 + lane_off; asm volatile("" : "+v"(pw));
#pragma unroll
        for (int r = 0; r < 16; ++r) {
#pragma unroll
            for (int d0 = 0; d0 < 4; ++d0) pw[d0 * 32] = (bf16_t)(cvt_pk_bf16(o[d0][r] * rli[r], 0.f) & 0xffffu);
            ROWWALK(pw, r); }
    } else {
        float sw[4];
#pragma unroll
        for (int d0 = 0; d0 < 4; ++d0) sw[d0] = subln[d0 * 32 + r32] * 0.8f;
        const bf16_t* pr = O1 + lane_off; asm volatile("" : "+v"(pr));
        float ssr[16];
#pragma unroll
        for (int r = 0; r < 16; ++r) { float sq = 0.f;
#pragma unroll
            for (int d0 = 0; d0 < 4; ++d0) { const float o1v = __uint_as_float(((unsigned)pr[d0 * 32]) << 16);
                const float y = o1v - lam * (o[d0][r] * rli[r]); o[d0][r] = y; sq += y * y; }
            ssr[r] = sq; ROWWALK(pr, r); }
#pragma unroll
        for (int m = 1; m < 32; m <<= 1)
#pragma unroll
            for (int r = 0; r < 16; ++r) ssr[r] += __shfl_xor(ssr[r], m);
        bf16_t* pw = Hd + lane_off; asm volatile("" : "+v"(pw));
#pragma unroll
        for (int r = 0; r < 16; ++r) { const float rstd = rsqrtf(ssr[r] * (1.f / 128.f) + EPS);
#pragma unroll
            for (int d0 = 0; d0 < 4; ++d0) pw[d0 * 32] = (bf16_t)(cvt_pk_bf16(o[d0][r] * rstd * sw[d0], 0.f) & 0xffffu);
            ROWWALK(pw, r); }
    }
#undef ROWWALK
    WAIT_BAR(0);
#undef DMA
#undef WAIT_BAR
}
#undef SBAR
}

struct Args { const float* in[23]; float* out; unsigned char* ws; int lo, hi; };
enum { I_X = 0, I_C, I_CTX, I_CCTX, I_WMOD, I_BMOD, I_NAW, I_WIN, I_QNW, I_KNW, I_LQ1, I_LK1, I_LQ2, I_LK2, I_SUBLN, I_POOLW, I_POOLS, I_WA, I_WB, I_WO, I_NMW, I_FF1, I_FF2 };
constexpr int LDS_BYTES = 131072 + 1024;

__device__ __forceinline__ void p0_transpose_item(const float* W, int K, int N, bf16_t* WT, LAS float* scr, int item, int lane) {
    const int nblk = N / 32, kb = item / nblk, nb = item % nblk, k0 = 64 * kb, n0 = 32 * nb;
#pragma unroll 8
    for (int i = 0; i < 32; ++i) { const int kk = 2 * i + (lane >> 5); scr[kk * 33 + (lane & 31)] = W[(size_t)(k0 + kk) * N + n0 + (lane & 31)]; }
    asm volatile("s_waitcnt lgkmcnt(0)" ::: "memory");
    const int c = lane & 7;
#pragma unroll
    for (int j = 0; j < 4; ++j) { const int n = (lane >> 3) + 8 * j; const LAS float* s = scr + (8 * c) * 33 + n;
        u32x4 o; o.x = cvt_pk_bf16(s[0 * 33], s[1 * 33]); o.y = cvt_pk_bf16(s[2 * 33], s[3 * 33]); o.z = cvt_pk_bf16(s[4 * 33], s[5 * 33]); o.w = cvt_pk_bf16(s[6 * 33], s[7 * 33]);
        *(u32x4*)(WT + (size_t)(n0 + n) * K + k0 + 8 * c) = o; }
    asm volatile("s_waitcnt lgkmcnt(0)" ::: "memory");
}

template <typename XT>
__device__ __forceinline__ void modulate_rows(const XT* X, int nrows, int rpw, const float* nw, const float* mod, int shift_off, int scale_off, int rows_per_batch, bf16_t* out, int gw, int NGW, int lane) {
    for (int m0 = gw * rpw; m0 < nrows; m0 += NGW * rpw) {
        const int r = rows_per_batch ? m0 / rows_per_batch : 4;
        const float* mr = mod + (size_t)r * NMOD;
        for (int mi = 0; mi < rpw; mi += 2) {
            const int m = m0 + mi;
            f32x4 v[2][8];
            if constexpr (sizeof(XT) == 4) {
#pragma unroll
                for (int q = 0; q < 2; ++q) { const f32x4* xr = (const f32x4*)((const float*)X + (size_t)(m + q) * DM) + lane;
#pragma unroll
                    for (int j = 0; j < 8; ++j) v[q][j] = __builtin_nontemporal_load(xr + 64 * j); }
            } else {
                u32x2 w[2][8];
#pragma unroll
                for (int q = 0; q < 2; ++q) { const u32x2* xr = (const u32x2*)((const bf16_t*)X + (size_t)(m + q) * DM) + lane;
#pragma unroll
                    for (int j = 0; j < 8; ++j) w[q][j] = xr[64 * j]; }
#pragma unroll
                for (int q = 0; q < 2; ++q)
#pragma unroll
                    for (int j = 0; j < 8; ++j) v[q][j] = (f32x4){bflo(w[q][j].x), bfhi(w[q][j].x), bflo(w[q][j].y), bfhi(w[q][j].y)};
            }
            float rstd[2];
#pragma unroll
            for (int q = 0; q < 2; ++q) { float ss = 0.f;
#pragma unroll
                for (int j = 0; j < 8; ++j) ss += (v[q][j].x * v[q][j].x + v[q][j].y * v[q][j].y) + (v[q][j].z * v[q][j].z + v[q][j].w * v[q][j].w);
                rstd[q] = rsqrtf(wave_sum(ss) * (1.f / DM) + EPS); }
#pragma unroll
            for (int j = 0; j < 8; ++j) { const int col = (lane + 64 * j) * 4;
                const f32x4 Ac = *(const f32x4*)(nw + col) * (*(const f32x4*)(mr + scale_off + col) + 1.0f), Bc = *(const f32x4*)(mr + shift_off + col);
#pragma unroll
                for (int q = 0; q < 2; ++q) { const f32x4 y = (v[q][j] * rstd[q]) * Ac + Bc;
                    u32x2 o; o.x = cvt_pk_bf16(y.x, y.y); o.y = cvt_pk_bf16(y.z, y.w);
                    *(u32x2*)(out + (size_t)(m + q) * DM + col) = o; } }
        }
    }
}

__device__ __forceinline__ void grid_bar(unsigned* ctr, unsigned k, int tid) {
    asm volatile("s_waitcnt vmcnt(0) lgkmcnt(0)" ::: "memory");
    __syncthreads();
    if (tid == 0) {
        __builtin_amdgcn_fence(__ATOMIC_RELEASE, "agent");
        asm volatile("s_waitcnt vmcnt(0)" ::: "memory");
        const unsigned G = gridDim.x, grp = blockIdx.x >> 5, ngrp = (G + 31u) >> 5, gsz = (grp + 1u) * 32u <= G ? 32u : G - grp * 32u;
        const unsigned old = __hip_atomic_fetch_add(ctr + 64 * (1 + grp), 1u, __ATOMIC_RELAXED, __HIP_MEMORY_SCOPE_AGENT);
        if (old + 1u == k * gsz) __hip_atomic_fetch_add(ctr, 1u, __ATOMIC_RELAXED, __HIP_MEMORY_SCOPE_AGENT);
        while (__hip_atomic_load(ctr, __ATOMIC_RELAXED, __HIP_MEMORY_SCOPE_AGENT) < k * ngrp) __builtin_amdgcn_s_sleep(1);
        __builtin_amdgcn_fence(__ATOMIC_ACQUIRE, "agent");
        asm volatile("s_waitcnt vmcnt(0)" ::: "memory");
    }
    __syncthreads();
}

__global__ void __launch_bounds__(512, 2) fwd_kernel(Args args) {
    extern __shared__ __attribute__((aligned(16))) unsigned char lds[];
    LAS unsigned char* ldsl = (LAS unsigned char*)lds;
    int wave_k = __builtin_amdgcn_readfirstlane((int)threadIdx.x >> 6); asm volatile("" : "+s"(wave_k));
    int lo, hi;
    { const Args __attribute__((address_space(4)))* A0 = (const Args __attribute__((address_space(4)))*)(unsigned long long)__builtin_amdgcn_kernarg_segment_ptr(); lo = A0->lo; hi = A0->hi; }
#define PH_VARS \
    const Args __attribute__((address_space(4)))* A_; { unsigned long long kp_ = (unsigned long long)__builtin_amdgcn_kernarg_segment_ptr(); asm volatile("" : "+s"(kp_)); A_ = (const Args __attribute__((address_space(4)))*)kp_; } \
    int tid = wave_k * 64 + lane_id_opaque(); asm volatile("" : "+v"(tid)); \
    const int lane = tid & 63, wave = __builtin_amdgcn_readfirstlane(tid >> 6); \
    const int G = gridDim.x, bx = blockIdx.x; \
    const int vcu = (G % 8 == 0) ? (bx % 8) * (G / 8) + bx / 8 : bx; \
    const int gw = vcu * 8 + wave, NGW = G * 8; \
    unsigned char* ws = A_->ws; \
    float* mod = (float*)(ws + WS_MOD); float* rope = (float*)(ws + WS_ROPE); \
    bf16_t* Win_t = (bf16_t*)(ws + WS_WIN); bf16_t* Wff1_t = (bf16_t*)(ws + WS_WFF1); bf16_t* Wff2_t = (bf16_t*)(ws + WS_WFF2); bf16_t* Wo_t = (bf16_t*)(ws + WS_WO); \
    bf16_t* Wa_t = (bf16_t*)(ws + WS_WA); bf16_t* Wb_t = (bf16_t*)(ws + WS_WB); bf16_t* Wp_t = (bf16_t*)(ws + WS_WP); \
    bf16_t* Hb = (bf16_t*)(ws + WS_H); bf16_t* HCb = (bf16_t*)(ws + WS_HC); bf16_t* QKV = (bf16_t*)(ws + WS_QKV); bf16_t* PG = (bf16_t*)(ws + WS_PG); \
    bf16_t* Db = (bf16_t*)(ws + WS_D); bf16_t* POOLED = (bf16_t*)(ws + WS_POOLED); bf16_t* OSUB = (bf16_t*)(ws + WS_OSUB); \
    bf16_t* HEADS = (bf16_t*)(ws + WS_HEADS); bf16_t* X1 = (bf16_t*)(ws + WS_X1); (void)X1; bf16_t* Mb = (bf16_t*)(ws + WS_M); bf16_t* H2 = (bf16_t*)(ws + WS_H2); bf16_t* Ub = (bf16_t*)(ws + WS_U); \
    (void)lane; (void)wave; (void)gw; (void)NGW; (void)mod; (void)rope; (void)Win_t; (void)Wff1_t; (void)Wff2_t; (void)Wo_t; (void)Wa_t; (void)Wb_t; (void)Wp_t; (void)Hb; (void)HCb; (void)QKV; (void)PG; \
    (void)Db; (void)POOLED; (void)OSUB; (void)HEADS; (void)Mb; (void)H2; (void)Ub; (void)bx; (void)vcu;
#ifndef PH_MASK
#define PH_MASK 0x3ff
#endif
#define IN(k) (((PH_MASK >> (k)) & 1) && lo <= (k) && (k) < hi)
#define SEAM(k) do { if (IN(k) && IN((k) + 1)) { if ((k) == 0) { cg::this_grid().sync(); } else { \
        const Args __attribute__((address_space(4)))* Ab_ = (const Args __attribute__((address_space(4)))*)(unsigned long long)__builtin_amdgcn_kernarg_segment_ptr(); \
        grid_bar((unsigned*)(Ab_->ws + WS_BAR), (unsigned)(k), wave_k * 64 + lane_id_opaque()); } } } while (0)

    if (IN(0)) { PH_VARS;
        {
            float* sc = (float*)lds;
            const float* c = A_->in[I_C]; const float* cc = A_->in[I_CCTX];
            for (int i = tid; i < 5 * DM; i += 512) { const int r = i / DM, k = i % DM; const float v = (r < 4) ? c[r * DM + k] : cc[k]; sc[i] = v / (1.0f + __expf(-v)); }
            __syncthreads();
            const float* wm = A_->in[I_WMOD]; const float* bm = A_->in[I_BMOD];
            float* red = (float*)(lds + 40960);
            for (int cb = bx; cb < NMOD / 48; cb += G) {
                const int col0 = cb * 48;
                if (tid < 504) {
                    const int cgp = tid % 12, ks = tid / 12;
                    float a[5][4];
#pragma unroll
                    for (int r = 0; r < 5; ++r)
#pragma unroll
                        for (int j = 0; j < 4; ++j) a[r][j] = 0.f;
                    for (int k = ks; k < DM; k += 42) {
                        const f32x4 w = *(const f32x4*)(wm + (size_t)k * NMOD + col0 + cgp * 4);
#pragma unroll
                        for (int r = 0; r < 5; ++r) { const float s = sc[r * DM + k]; a[r][0] += s * w.x; a[r][1] += s * w.y; a[r][2] += s * w.z; a[r][3] += s * w.w; }
                    }
#pragma unroll
                    for (int r = 0; r < 5; ++r)
#pragma unroll
                        for (int j = 0; j < 4; ++j) red[(r * 4 + j) * 504 + tid] = a[r][j];
                }
                __syncthreads();
                if (tid < 240) { const int r = tid / 48, ccol = tid % 48, cgp = ccol / 4, j = ccol % 4; float s = 0.f;
                    for (int ks = 0; ks < 42; ++ks) s += red[(r * 4 + j) * 504 + ks * 12 + cgp];
                    mod[r * NMOD + col0 + ccol] = s + bm[col0 + ccol]; }
                __syncthreads();
            }
            if (bx == 0 && tid <= 16) __hip_atomic_store((unsigned*)(ws + WS_BAR) + 64 * tid, 0u, __ATOMIC_RELAXED, __HIP_MEMORY_SCOPE_AGENT);
            if (bx == 0) for (int i = tid; i < 128 * 16; i += 512) { const int pos = i >> 4, f = i & 15;
                const float inv = powf(10000.0f, -(float)(2 * f) / 32.0f); float sn, cs; sincosf((float)pos * inv, &sn, &cs); rope[2 * i] = cs; rope[2 * i + 1] = sn; }
            __syncthreads();
        }
        LAS float* scr = (LAS float*)(ldsl + wave * 16384);
        constexpr int I_IN = (DM / 64) * (INW / 32), I_F1 = (DM / 64) * (DFF / 32), I_F2 = (DFF / 64) * (DM / 32), I_O = (DM / 64) * (DM / 32), I_A = (1024 / 64) * (DM / 32), I_P = 4 * 8;
        constexpr int NITEMS = I_IN + I_F1 + I_F2 + I_O + 2 * I_A + 4 * I_P;
        for (int it = gw; it < NITEMS; it += NGW) {
            int r = it;
            if (r < I_IN) { p0_transpose_item(A_->in[I_WIN], DM, INW, Win_t, scr, r, lane); continue; } r -= I_IN;
            if (r < I_F1) { p0_transpose_item(A_->in[I_FF1], DM, DFF, Wff1_t, scr, r, lane); continue; } r -= I_F1;
            if (r < I_F2) { p0_transpose_item(A_->in[I_FF2], DFF, DM, Wff2_t, scr, r, lane); continue; } r -= I_F2;
            if (r < I_O) { p0_transpose_item(A_->in[I_WO], DM, DM, Wo_t, scr, r, lane); continue; } r -= I_O;
            if (r < I_A) { p0_transpose_item(A_->in[I_WA], 1024, DM, Wa_t, scr, r, lane); continue; } r -= I_A;
            if (r < I_A) { p0_transpose_item(A_->in[I_WB], 1024, DM, Wb_t, scr, r, lane); continue; } r -= I_A;
            const int gq = r / I_P; r -= gq * I_P;
            p0_transpose_item(A_->in[I_POOLW] + (size_t)gq * 65536, 256, 256, Wp_t + (size_t)gq * 65536, scr, r, lane);
        }
    }
    SEAM(0);
    if (IN(1)) { PH_VARS;
        modulate_rows<float>(A_->in[I_X], MTOK, 16, A_->in[I_NAW], mod, 0, DM, SEQ, Hb, gw, NGW, lane);
        modulate_rows<float>(A_->in[I_CTX], NB * CTX, 4, A_->in[I_NAW], mod, 0, DM, 0, HCb, gw, NGW, lane);
    }
    SEAM(1);
    if (IN(2)) { PH_VARS;
        { pg8::Gemm g{Hb, Win_t, MTOK, INW, DM, DM, DM, 0, 128, 128}; pg8::StaticOrder S; S.init(MTOK, INW, G, bx);
          pg8::Epi<pg8::E_G1> E{QKV, PG, nullptr, nullptr, nullptr, nullptr};
          pg8::gemm_phase(tid, ldsl, g, S, E); }
        { pg8::Gemm g{HCb, Win_t + (size_t)1024 * DM, NB * CTX, 2048, DM, DM, DM, 0, 128, 128}; pg8::StaticOrder S; S.init(NB * CTX, 2048, G, bx);
          pg8::Epi<pg8::E_CTX> E{QKV, nullptr, nullptr, nullptr, nullptr, nullptr};
          pg8::gemm_phase(tid, ldsl, g, S, E); }
    }
    SEAM(2);
    if (IN(3)) { PH_VARS;
        const float* qnw = A_->in[I_QNW]; const float* knw = A_->in[I_KNW];
        for (int R = gw; R < MKV; R += NGW) {
            const int t = R % SKV; const bool isc = t >= SEQ;
            const int head = lane >> 1, half = lane & 1;
            bf16_t* p = QKV + (size_t)R * LDQKV + head * 64 + half * 32;
            float y[32];
            { const u32x4 a = *(const u32x4*)p, b = *(const u32x4*)(p + 8), c = *(const u32x4*)(p + 16), d = *(const u32x4*)(p + 24);
              const unsigned w[16] = {a.x, a.y, a.z, a.w, b.x, b.y, b.z, b.w, c.x, c.y, c.z, c.w, d.x, d.y, d.z, d.w};
#pragma unroll
              for (int i = 0; i < 16; ++i) { y[2 * i] = bflo(w[i]); y[2 * i + 1] = bfhi(w[i]); } }
            float ss = 0.f;
#pragma unroll
            for (int i = 0; i < 32; ++i) ss += y[i] * y[i];
            ss += __shfl_xor(ss, 1);
            const float rstd = rsqrtf(ss * (1.f / 64.f) + EPS);
            const float* nw = (head < 16 ? qnw : knw) + half * 32;
#pragma unroll
            for (int i = 0; i < 32; ++i) y[i] = y[i] * rstd * nw[i];
            if (head < 16) {
#pragma unroll
                for (int i = 0; i < 32; ++i) y[i] *= att::QSCALE; }
            if (!isc) {
                const int pos = half ? (t & 63) : (t >> 6);
                const float* tb = rope + pos * 32;
#pragma unroll
                for (int i = 0; i < 16; ++i) { const float cs = tb[2 * i], sn = tb[2 * i + 1], a = y[i], b = y[i + 16]; y[i] = a * cs - b * sn; y[i + 16] = a * sn + b * cs; }
            }
            if (!isc || head >= 16) {
                u32x4 o[4];
#pragma unroll
                for (int q = 0; q < 4; ++q) { o[q].x = cvt_pk_bf16(y[8 * q], y[8 * q + 1]); o[q].y = cvt_pk_bf16(y[8 * q + 2], y[8 * q + 3]); o[q].z = cvt_pk_bf16(y[8 * q + 4], y[8 * q + 5]); o[q].w = cvt_pk_bf16(y[8 * q + 6], y[8 * q + 7]); }
                *(u32x4*)p = o[0]; *(u32x4*)(p + 8) = o[1]; *(u32x4*)(p + 16) = o[2]; *(u32x4*)(p + 24) = o[3];
            }
        }
        for (long it = (long)vcu * 512 + tid; it < (long)MTOK * 128; it += (long)G * 512) {
            const int row = (int)(it >> 7), ch = (int)(it & 127), gq = ch >> 5, w = 2 << gq;
            const int t = row & (SEQ - 1), rb = row - t;
            const int l0 = max(t - w / 2, 0), h0 = min(t + w - w / 2, SEQ);
            float s[8];
#pragma unroll
            for (int i = 0; i < 8; ++i) s[i] = 0.f;
            for (int tt = l0; tt < h0; ++tt) { const u32x4 a = *(const u32x4*)(PG + (size_t)(rb + tt) * LDPG + ch * 8);
                s[0] += bflo(a.x); s[1] += bfhi(a.x); s[2] += bflo(a.y); s[3] += bfhi(a.y); s[4] += bflo(a.z); s[5] += bfhi(a.z); s[6] += bflo(a.w); s[7] += bfhi(a.w); }
            const float inv = 1.0f / (float)(h0 - l0);
            const u32x4 a = *(const u32x4*)(PG + (size_t)row * LDPG + ch * 8);
            u32x4 o; o.x = cvt_pk_bf16(s[0] * inv - bflo(a.x), s[1] * inv - bfhi(a.x)); o.y = cvt_pk_bf16(s[2] * inv - bflo(a.y), s[3] * inv - bfhi(a.y));
            o.z = cvt_pk_bf16(s[4] * inv - bflo(a.z), s[5] * inv - bfhi(a.z)); o.w = cvt_pk_bf16(s[6] * inv - bflo(a.w), s[7] * inv - bfhi(a.w));
            *(u32x4*)(Db + (size_t)row * 1024 + ch * 8) = o;
        }
    }
    SEAM(3);
    if (IN(4)) { PH_VARS;
        { pg8::Gemm g{Db, Wp_t, MTOK, 1024, 256, 1024, 256, 256, 128, 128}; pg8::StaticOrder S; S.init(MTOK, 1024, G, bx);
          pg8::Epi<pg8::E_POOL> E{POOLED, nullptr, nullptr, nullptr, A_->in[I_POOLS], nullptr};
          pg8::gemm_phase(tid, ldsl, g, S, E); }
        __syncthreads();
    }
    if (IN(4)) { PH_VARS;
        float KN; { float w = fabsf(A_->in[I_KNW][lane]);
#pragma unroll
            for (int o = 1; o < 64; o <<= 1) w = fmaxf(w, __shfl_xor(w, o));
            KN = 8.0f * w * 1.01f; }
        const float l1 = wave_sum(A_->in[I_LQ1][lane] * A_->in[I_LK1][lane]), l2 = wave_sum(A_->in[I_LQ2][lane] * A_->in[I_LK2][lane]);
        const float lam_init = 0.2f, lam = __expf(l1) - __expf(l2) + lam_init;
        const float* subln = A_->in[I_SUBLN];
        for (int U = vcu; U < NB * 8 * (SEQ / 256); U += G) {
            const int bh = U >> 5, qb = U & 31, b = bh >> 3, h = bh & 7;
            const bf16_t* base = QKV + (size_t)b * SKV * LDQKV;
            const bf16_t* qp = base + (size_t)qb * 256 * LDQKV + h * 128; const bf16_t* kp = base + 1024 + h * 128; const bf16_t* vp = base + 2048 + h * 128;
            bf16_t* o1 = OSUB + (size_t)(b * SEQ + qb * 256) * 1024 + h * 128; bf16_t* hd = HEADS + (size_t)(b * SEQ + qb * 256) * 1024 + h * 128;
            att::attn_unit<false>(qp, kp, vp, o1, hd, lam, subln, SKV, KN, (char*)lds, ldsl, wave_k);
            att::attn_unit<true>(qp + 64, kp + 64, vp, o1, hd, lam, subln, SKV, KN, (char*)lds, ldsl, wave_k);
        }
    }
    SEAM(4);
    if (IN(5)) { PH_VARS;
        { pg8::Gemm g{HEADS, Wa_t, MTOK, DM, 1024, 1024, 1024, 0, 128, 128}; pg8::StaticOrder S; S.init(MTOK, DM, G, bx);
          pg8::Epi<pg8::E_YA> E{Mb, nullptr, nullptr, nullptr, nullptr, PG};
          pg8::gemm_phase(tid, ldsl, g, S, E); }
        __syncthreads();
        { pg8::Gemm g{POOLED, Wb_t, MTOK, DM, 1024, 1024, 1024, 0, 128, 128}; pg8::StaticOrder S; S.init(MTOK, DM, G, bx);
          pg8::Epi<pg8::E_YB> E{Mb, nullptr, nullptr, nullptr, nullptr, PG};
          pg8::gemm_phase(tid, ldsl, g, S, E); }
    }
    SEAM(5);
    if (IN(6)) { PH_VARS;
        pg8::Gemm g{Mb, Wo_t, MTOK, DM, DM, DM, DM, 0, 128, 128}; pg8::StaticOrder S; S.init(MTOK, DM, G, bx);
        pg8::Epi<pg8::E_WO> E{X1, nullptr, nullptr, A_->in[I_X], mod + 2 * DM, nullptr};
        pg8::gemm_phase(tid, ldsl, g, S, E);
    }
    SEAM(6);
    if (IN(7)) { PH_VARS; modulate_rows<bf16_t>(X1, MTOK, 16, A_->in[I_NMW], mod, 3 * DM, 4 * DM, SEQ, H2, gw, NGW, lane); }
    SEAM(7);
    if (IN(8)) { PH_VARS;
        pg8::Gemm g{H2, Wff1_t, MTOK, DFF, DM, DM, DM, 0, 128, 128}; pg8::StaticOrder S; S.init(MTOK, DFF, G, bx);
        pg8::Epi<pg8::E_FF1> E{Ub, nullptr, nullptr, nullptr, nullptr, nullptr};
        pg8::gemm_phase(tid, ldsl, g, S, E);
    }
    SEAM(8);
    if (IN(9)) { PH_VARS;
        pg8::Gemm g{Ub, Wff2_t, MTOK, DM, DFF, 64, DFF, 0, (size_t)MTOK * 128, 128};   pg8::StaticOrder S; S.init(MTOK, DM, G, bx);
        pg8::Epi<pg8::E_FF2> E{nullptr, nullptr, A_->out, nullptr, mod + 5 * DM, X1};
        pg8::gemm_phase(tid, ldsl, g, S, E);
    }
#undef IN
#undef SEAM
}

extern "C" void kernel_launch(void* const* d_in, const int* in_sizes, int n_in, void* d_out, int out_size, void* d_ws, size_t ws_size, hipStream_t stream) {
    static int grid = 0;
    if (grid == 0) {
        if (n_in != 23 || in_sizes[0] != MTOK * DM || out_size != MTOK * DM || ws_size < WS_END) {
            fprintf(stderr, "kernel_launch: shape mismatch n_in %d in0 %d out %d ws %zu (need %zu)\n", n_in, n_in > 0 ? in_sizes[0] : -1, out_size, ws_size, (size_t)WS_END); grid = -1; return; }
        int dev = 0, cus = 0, per_cu = 0;
        hipGetDevice(&dev); hipDeviceGetAttribute(&cus, hipDeviceAttributeMultiprocessorCount, dev);
        if (hipFuncSetAttribute((const void*)fwd_kernel, hipFuncAttributeMaxDynamicSharedMemorySize, LDS_BYTES) != hipSuccess) { fprintf(stderr, "kernel_launch: hipFuncSetAttribute failed\n"); grid = -1; return; }
        hipOccupancyMaxActiveBlocksPerMultiprocessor(&per_cu, (const void*)fwd_kernel, 512, LDS_BYTES);
        if (per_cu < 1) { fprintf(stderr, "kernel_launch: occupancy query says %d blocks/CU\n", per_cu); per_cu = 1; }
        (void)hipGetLastError();
        grid = cus;
    }
    if (grid < 0) return;
#if MK_MULTI
    if (hipMemsetAsync((char*)d_ws + WS_BAR, 0, 256, stream) != hipSuccess) { fprintf(stderr, "kernel_launch: memset failed\n"); return; }
#endif
    Args a{};
    for (int i = 0; i < 23; ++i) a.in[i] = (const float*)d_in[i];
    a.out = (float*)d_out; a.ws = (unsigned char*)d_ws;
#if MK_MULTI
    for (int p = 0; p < NPHASE; ++p) for (int rep = 0; rep < 1 + ((MK_REP_MASK >> p) & 1); ++rep) { a.lo = p; a.hi = p + 1; hipLaunchKernelGGL(fwd_kernel, dim3(grid), dim3(512), LDS_BYTES, stream, a); }
#else
    a.lo = 0; a.hi = NPHASE;
    void* kargs[] = {&a};
    hipError_t e = hipLaunchCooperativeKernel((const void*)fwd_kernel, dim3(grid), dim3(512), kargs, LDS_BYTES, stream);
    if (e != hipSuccess) fprintf(stderr, "cooperative launch failed: %s (grid %d)\n", hipGetErrorString(e), grid);
#endif
}
```

```cpp
#include <hip/hip_runtime.h>
#include <hip/hip_cooperative_groups.h>
#include <cstdio>
#include <cstdint>
namespace cg = cooperative_groups;

#ifndef MK_REP_MASK
#define MK_REP_MASK 0
#endif
#ifndef MK_MULTI
#define MK_MULTI 0
#endif

#define LAS __attribute__((address_space(3)))
typedef unsigned short bf16_t;
typedef short bf16x8 __attribute__((ext_vector_type(8)));
typedef short s16x4 __attribute__((ext_vector_type(4)));
typedef float f32x4 __attribute__((ext_vector_type(4)));
typedef float f32x16 __attribute__((ext_vector_type(16)));
typedef unsigned u32x4 __attribute__((ext_vector_type(4)));
typedef unsigned u32x2 __attribute__((ext_vector_type(2)));

constexpr int DM = 2048, NB = 4, SEQ = 8192, CTX = 256, MTOK = NB * SEQ, SKV = SEQ + CTX, MKV = NB * SKV;
constexpr int INW = 8192, DFF = 8192, NMOD = 6 * DM;
constexpr int LDQKV = 3072, LDPG = 5120;
constexpr float EPS = 1e-6f;
constexpr int NPHASE = 10;

constexpr size_t MiB = 1u << 20;
constexpr size_t WS_MOD = 0, WS_ROPE = 256 * 1024, WS_BAR = 512 * 1024;
constexpr size_t WS_WIN = 1 * MiB, WS_WFF1 = 33 * MiB, WS_WFF2 = 65 * MiB, WS_WO = 97 * MiB, WS_WA = 105 * MiB, WS_WB = 109 * MiB, WS_WP = 113 * MiB;
constexpr size_t WS_H = 114 * MiB, WS_HC = 242 * MiB, WS_QKV = 246 * MiB, WS_PG = 444 * MiB, WS_D = 764 * MiB, WS_POOLED = 828 * MiB, WS_OSUB = 892 * MiB;
constexpr size_t WS_HEADS = WS_OSUB + 64 * MiB, WS_X1 = WS_D  , WS_M = WS_H, WS_H2 = WS_OSUB, WS_U = WS_QKV, WS_END = 1020 * MiB;
static_assert(WS_QKV + (size_t)MKV * LDQKV * 2 <= WS_PG && WS_PG + (size_t)MTOK * LDPG * 2 <= WS_D && WS_U + (size_t)MTOK * DFF * 2 <= WS_D, "ws map");

__device__ __forceinline__ unsigned cvt_pk_bf16(float lo, float hi) { unsigned r; asm volatile("v_cvt_pk_bf16_f32 %0, %1, %2" : "=v"(r) : "v"(lo), "v"(hi)); return r; }
__device__ __forceinline__ float bflo(unsigned w) { return __uint_as_float(w << 16); }
__device__ __forceinline__ float bfhi(unsigned w) { return __uint_as_float(w & 0xffff0000u); }
__device__ __forceinline__ float wave_sum(float v) {
#pragma unroll
    for (int o = 1; o < 64; o <<= 1) v += __shfl_xor(v, o);
    return v;
}
__device__ __forceinline__ float sigmoidf_(float v) { return __builtin_amdgcn_rcpf(1.0f + __builtin_amdgcn_exp2f(-1.4426950408889634f * v)); }

__device__ __forceinline__ int lane_id_opaque() { unsigned m = ~0u; asm volatile("" : "+s"(m)); return (int)__builtin_amdgcn_mbcnt_hi(m, __builtin_amdgcn_mbcnt_lo(m, 0u)); }

namespace pg8 {
constexpr int BM = 256, BK = 64, HALF = 128, HTB = HALF * BK * 2, STAGE_BYTES = 8 * HTB, NXCD = 8, WGM = 8;
__host__ __device__ __forceinline__ int lds_byte(int r, int c) { const int st = (r >> 4) * 2 + (c >> 5), rr = r & 15, cc = c & 31, ob = rr * 64 + cc * 2; return st * 1024 + (ob ^ (((ob >> 9) & 1) << 5)); }
__host__ __device__ __forceinline__ void stage_rc(int b, int& R, int& C) { const int st = b / 1024, sb = b % 1024, swz = sb ^ (((sb >> 9) & 1) << 5); R = (st >> 1) * 16 + swz / 64; C = (st & 1) * 32 + (swz % 64) / 2; }
__host__ __device__ __forceinline__ int perm32(int rho) { const int n = rho >> 4, i = rho & 15; return 8 * (i >> 2) + 4 * n + (i & 3); }

struct Unit { int pm, pn; };
struct Gemm { const bf16_t* A; const bf16_t* Bt; int M, N, K, lda, ldb, akoff; size_t ksa, ksb; };

struct StaticOrder {
    int nM, nN, nwg, G, c;
    __device__ void init(int M, int N, int G_, int c_) { nM = M / BM; nN = N / BM; nwg = nM * nN; G = G_; c = c_; }
    __device__ bool next(int i, Unit& u) const {
        const long L = (long)i * G + c; if (L >= nwg) return false;
        int wgid = (int)L; { const int q = nwg / NXCD, r = nwg % NXCD, xcd = wgid % NXCD, off = wgid / NXCD; wgid = (xcd < r ? xcd * (q + 1) : r * (q + 1) + (xcd - r) * q) + off; }
        const int nig = WGM * nN, gid = wgid / nig, fm = gid * WGM, gsz = (nM - fm) < WGM ? (nM - fm) : WGM;
        u.pm = fm + ((wgid % nig) % gsz); u.pn = (wgid % nig) / gsz; return true;
    }
};

enum { E_G1 = 0, E_CTX, E_POOL, E_YA, E_YB, E_WO, E_FF1, E_FF2 };
template <int MODE> struct Epi {
    bf16_t* o16; bf16_t* o16b; float* o32; const float* x32; const float* vec; const bf16_t* g16;
    static __device__ __forceinline__ u32x4 pack8(const f32x4& v0, const f32x4& v1) { u32x4 w; w.x = cvt_pk_bf16(v0[0], v0[1]); w.y = cvt_pk_bf16(v0[2], v0[3]); w.z = cvt_pk_bf16(v1[0], v1[1]); w.w = cvt_pk_bf16(v1[2], v1[3]); return w; }
    static __device__ __forceinline__ void mul8(f32x4& v0, f32x4& v1, const u32x4& g) { v0[0] *= bflo(g.x); v0[1] *= bfhi(g.x); v0[2] *= bflo(g.y); v0[3] *= bfhi(g.y); v1[0] *= bflo(g.z); v1[1] *= bfhi(g.z); v1[2] *= bflo(g.w); v1[3] *= bfhi(g.w); }
    static __device__ __forceinline__ void add8(f32x4& v0, f32x4& v1, const u32x4& a) { v0[0] += bflo(a.x); v0[1] += bfhi(a.x); v0[2] += bflo(a.y); v0[3] += bfhi(a.y); v1[0] += bflo(a.z); v1[1] += bfhi(a.z); v1[2] += bflo(a.w); v1[3] += bfhi(a.w); }
    __device__ __forceinline__ void operator()(const f32x4 (&acc)[2][2][4][2], const Unit& u, int wr, int wc, int fr, int fq) const {
        const int rowt = u.pm * BM + wr * 64 + fr, colt = u.pn * BM + wc * 32 + 8 * fq;
        if constexpr (MODE == E_WO || MODE == E_FF2) {
            const float* gv = vec + (size_t)(rowt >> 13) * NMOD + colt;
            f32x4 g[2][2];
#pragma unroll
            for (int bj = 0; bj < 2; ++bj) { g[bj][0] = *(const f32x4*)(gv + bj * HALF); g[bj][1] = *(const f32x4*)(gv + bj * HALF + 4); }
#pragma unroll
            for (int ai = 0; ai < 2; ++ai) {
                if constexpr (MODE == E_WO) {
                    f32x4 xb[4][2][2];
#pragma unroll
                    for (int m = 0; m < 4; ++m)
#pragma unroll
                        for (int bj = 0; bj < 2; ++bj) { const size_t off = (size_t)(rowt + ai * HALF + m * 16) * DM + colt + bj * HALF;
                            xb[m][bj][0] = __builtin_nontemporal_load((const f32x4*)(x32 + off)); xb[m][bj][1] = __builtin_nontemporal_load((const f32x4*)(x32 + off + 4)); }
#pragma unroll
                    for (int m = 0; m < 4; ++m)
#pragma unroll
                        for (int bj = 0; bj < 2; ++bj) { const size_t off = (size_t)(rowt + ai * HALF + m * 16) * DM + colt + bj * HALF;
                            *(u32x4*)(o16 + off) = pack8(xb[m][bj][0] + g[bj][0] * acc[ai][bj][m][0], xb[m][bj][1] + g[bj][1] * acc[ai][bj][m][1]); }
                } else {
                    u32x4 xb[4][2];
#pragma unroll
                    for (int m = 0; m < 4; ++m)
#pragma unroll
                        for (int bj = 0; bj < 2; ++bj) xb[m][bj] = *(const u32x4*)(g16 + (size_t)(rowt + ai * HALF + m * 16) * DM + colt + bj * HALF);
#pragma unroll
                    for (int m = 0; m < 4; ++m)
#pragma unroll
                        for (int bj = 0; bj < 2; ++bj) { const size_t off = (size_t)(rowt + ai * HALF + m * 16) * DM + colt + bj * HALF;
                            f32x4 v0 = g[bj][0] * acc[ai][bj][m][0], v1 = g[bj][1] * acc[ai][bj][m][1];
                            add8(v0, v1, xb[m][bj]);
                            *(f32x4*)(o32 + off) = v0; *(f32x4*)(o32 + off + 4) = v1; }
                }
            }
        } else if constexpr (MODE == E_YA || MODE == E_YB) {
#pragma unroll
            for (int ai = 0; ai < 2; ++ai) {
                u32x4 gb[4][2], mb[4][2];
#pragma unroll
                for (int m = 0; m < 4; ++m)
#pragma unroll
                    for (int bj = 0; bj < 2; ++bj) { const int row = rowt + ai * HALF + m * 16, col = colt + bj * HALF;
                        gb[m][bj] = *(const u32x4*)(g16 + (size_t)row * LDPG + 1024 + (MODE == E_YB ? DM : 0) + col);
                        if constexpr (MODE == E_YB) mb[m][bj] = *(const u32x4*)(o16 + (size_t)row * DM + col); }
#pragma unroll
                for (int m = 0; m < 4; ++m)
#pragma unroll
                    for (int bj = 0; bj < 2; ++bj) { const int row = rowt + ai * HALF + m * 16, col = colt + bj * HALF;
                        f32x4 v0 = acc[ai][bj][m][0], v1 = acc[ai][bj][m][1];
                        mul8(v0, v1, gb[m][bj]);
                        if constexpr (MODE == E_YB) add8(v0, v1, mb[m][bj]);
                        *(u32x4*)(o16 + (size_t)row * DM + col) = pack8(v0, v1); }
            }
        } else {
#pragma unroll
        for (int ai = 0; ai < 2; ++ai)
#pragma unroll
            for (int m = 0; m < 4; ++m) {
                const int row = rowt + ai * HALF + m * 16;
#pragma unroll
                for (int bj = 0; bj < 2; ++bj) {
                    const int col = colt + bj * HALF;
                    f32x4 v0 = acc[ai][bj][m][0], v1 = acc[ai][bj][m][1];
                    if constexpr (MODE == E_G1) {
                        bf16_t* p;
                        if (u.pn < 12) { p = o16 + (size_t)(row + (row >> 13) * CTX) * LDQKV + col; }
                        else { p = o16b + (size_t)row * LDPG + (col - 3072);
                            if (u.pn >= 16) {
#pragma unroll
                                for (int j = 0; j < 4; ++j) { v0[j] = sigmoidf_(v0[j]); v1[j] = sigmoidf_(v1[j]); } } }
                        *(u32x4*)p = pack8(v0, v1);
                    } else if constexpr (MODE == E_CTX) {
                        *(u32x4*)(o16 + (size_t)(u.pm * SKV + SEQ + (row - u.pm * BM)) * LDQKV + 1024 + col) = pack8(v0, v1);
                    } else if constexpr (MODE == E_POOL) {
                        const f32x4 s0 = *(const f32x4*)(vec + col), s1 = *(const f32x4*)(vec + col + 4);
                        v0 = v0 * s0; v1 = v1 * s1;
                        *(u32x4*)(o16 + (size_t)row * 1024 + col) = pack8(v0, v1);
                    } else if constexpr (MODE == E_FF1) {
#pragma unroll
                        for (int j = 0; j < 4; ++j) { const float a = fmaxf(v0[j], 0.f), b = fmaxf(v1[j], 0.f); v0[j] = a * a; v1[j] = b * b; }
                        __builtin_nontemporal_store(pack8(v0, v1), (u32x4*)(o16 + (size_t)(col >> 6) * ((size_t)MTOK * 64) + (size_t)row * 64 + (col & 63)));
                    }
                }
            }
        }
    }
};

template <class EpiT>
__device__ __forceinline__ void gemm_phase(const int tid, LAS unsigned char* lds, const Gemm g, const StaticOrder& S, const EpiT& E) {
    const int wid = __builtin_amdgcn_readfirstlane(tid >> 6), lane = tid & 63, wr = wid >> 2, wc = wid & 3, fr = lane & 15, fq = lane >> 4;
    const int K = g.K, nt = K / BK;
    unsigned voffA[2], voffB[2];
#pragma unroll
    for (int i = 0; i < 2; ++i) { int R, C; stage_rc(tid * 16 + i * 8192, R, C); const int Rb = (R & ~31) + perm32(R & 31);
        voffA[i] = (unsigned)(R * g.lda + C) * 2u; voffB[i] = (unsigned)(Rb * g.ldb + C) * 2u; }
    const size_t kstepA = g.ksa, kstepB = g.ksb;
    const size_t hstepA = (size_t)HALF * g.lda * 2, hstepB = (size_t)HALF * g.ldb * 2;
    const size_t tstepA = 2 * hstepA, tstepB = 2 * hstepB;
    const unsigned ldsw = (unsigned)wid * 1024u;
    const int aoff = lds_byte(wr * 64 + fr, fq * 8), boff = lds_byte(wc * 32 + fr, fq * 8);
#define PG8_SA(b, h) (((b) * 2 + (h)) * HTB)
#define PG8_SB(b, h) ((4 + (b) * 2 + (h)) * HTB)
#define PG8_STAGE(bufoff, gbase, voff) do { _Pragma("unroll") for (int _i = 0; _i < 2; ++_i) \
        __builtin_amdgcn_global_load_lds((const unsigned*)((const char*)(gbase) + (voff)[_i]), (LAS unsigned*)(lds + (bufoff) + ldsw + _i * 8192), 16, 0, 0); } while (0)
#define PG8_LDA(dst, b, h) do { _Pragma("unroll") for (int m = 0; m < 4; ++m) _Pragma("unroll") for (int k = 0; k < 2; ++k) dst[m][k] = *(const LAS bf16x8*)(lds + PG8_SA(b, h) + aoff + m * 2048 + k * 1024); } while (0)
#define PG8_LDB(dst, b, h) do { _Pragma("unroll") for (int n = 0; n < 2; ++n) _Pragma("unroll") for (int k = 0; k < 2; ++k) dst[n][k] = *(const LAS bf16x8*)(lds + PG8_SB(b, h) + boff + n * 2048 + k * 1024); } while (0)
#define PG8_MMA(ai, bj, At, Bt) do { __builtin_amdgcn_s_setprio(1); _Pragma("unroll") for (int m = 0; m < 4; ++m) _Pragma("unroll") for (int n = 0; n < 2; ++n) _Pragma("unroll") for (int k = 0; k < 2; ++k) \
        acc[ai][bj][m][n] = __builtin_amdgcn_mfma_f32_16x16x32_bf16(Bt[n][k], At[m][k], acc[ai][bj][m][n], 0, 0, 0); __builtin_amdgcn_s_setprio(0); } while (0)
#define PG8_WAIT_V(n) asm volatile("s_waitcnt vmcnt(" #n ")" ::: "memory")
#define PG8_WAIT_L(n) asm volatile("s_waitcnt lgkmcnt(" #n ")" ::: "memory")
#define PG8_BAR __builtin_amdgcn_s_barrier()
#define PG8_SCHED __builtin_amdgcn_sched_barrier(0)
    Unit cur, nxt; int ui = 0;
    if (!S.next(0, cur)) return;
    f32x4 acc[2][2][4][2];
#pragma unroll
    for (int a = 0; a < 2; ++a)
#pragma unroll
        for (int b = 0; b < 2; ++b)
#pragma unroll
            for (int m = 0; m < 4; ++m)
#pragma unroll
                for (int n = 0; n < 2; ++n) acc[a][b][m][n] = (f32x4){0.f, 0.f, 0.f, 0.f};
    bf16x8 At[4][2], B0[2][2], B1[2][2];
    const char* cA = (const char*)g.A + (size_t)cur.pm * tstepA + (size_t)cur.pn * g.akoff * 2; const char* cB = (const char*)g.Bt + (size_t)cur.pn * tstepB;
    PG8_STAGE(PG8_SB(0, 0), cB, voffB); PG8_STAGE(PG8_SB(0, 1), cB + hstepB, voffB); PG8_STAGE(PG8_SA(0, 0), cA, voffA); PG8_STAGE(PG8_SA(0, 1), cA + hstepA, voffA);
    if (wr == 1) PG8_BAR;
    PG8_WAIT_V(2); PG8_BAR;
    PG8_STAGE(PG8_SB(1, 0), cB + kstepB, voffB); PG8_STAGE(PG8_SA(1, 0), cA + kstepA, voffA); PG8_STAGE(PG8_SB(1, 1), cB + hstepB + kstepB, voffB);
    PG8_WAIT_V(6); PG8_BAR;
    for (;;) {
        const bool has_next = S.next(ui + 1, nxt);
        const char* nA = has_next ? (const char*)g.A + (size_t)nxt.pm * tstepA + (size_t)nxt.pn * g.akoff * 2 : cA; const char* nB = has_next ? (const char*)g.Bt + (size_t)nxt.pn * tstepB : cB;
        for (int t = 0; t < nt; t += 2) {
            const bool last = (t == nt - 2);
            const char* a1 = cA + (size_t)(t + 1) * kstepA;
            const char* a2 = last ? nA : cA + (size_t)(t + 2) * kstepA; const char* b2 = last ? nB : cB + (size_t)(t + 2) * kstepB;
            const char* a3 = a2 + kstepA; const char* b3 = b2 + kstepB;
            PG8_LDB(B0, 0, 0); PG8_LDB(B1, 0, 1); PG8_SCHED; PG8_LDA(At, 0, 0); PG8_STAGE(PG8_SA(1, 1), a1 + hstepA, voffA);
            PG8_WAIT_V(8); PG8_WAIT_L(0); PG8_BAR; PG8_MMA(0, 0, At, B0); PG8_MMA(0, 1, At, B1); PG8_BAR; PG8_SCHED;
            PG8_LDA(At, 0, 1); PG8_STAGE(PG8_SB(0, 0), b2, voffB); PG8_STAGE(PG8_SB(0, 1), b2 + hstepB, voffB); PG8_STAGE(PG8_SA(0, 0), a2, voffA);
            PG8_WAIT_V(8); PG8_WAIT_L(0); PG8_BAR; PG8_MMA(1, 0, At, B0); PG8_MMA(1, 1, At, B1); PG8_BAR; PG8_SCHED;
            PG8_LDB(B0, 1, 0); PG8_LDB(B1, 1, 1); PG8_SCHED; PG8_LDA(At, 1, 0); PG8_STAGE(PG8_SA(0, 1), a2 + hstepA, voffA);
            PG8_WAIT_V(8); PG8_WAIT_L(0); PG8_BAR; PG8_MMA(0, 0, At, B0); PG8_MMA(0, 1, At, B1); PG8_BAR; PG8_SCHED;
            PG8_LDA(At, 1, 1); PG8_STAGE(PG8_SB(1, 0), b3, voffB); PG8_STAGE(PG8_SB(1, 1), b3 + hstepB, voffB); PG8_STAGE(PG8_SA(1, 0), a3, voffA);
            PG8_WAIT_V(8); PG8_WAIT_L(0); PG8_BAR; PG8_MMA(1, 0, At, B0); PG8_MMA(1, 1, At, B1); PG8_BAR; PG8_SCHED;
        }
        if (wr == 0) PG8_BAR;
        E(acc, cur, wr, wc, fr, fq);
        if (!has_next) break;
#pragma unroll
        for (int a = 0; a < 2; ++a)
#pragma unroll
            for (int b = 0; b < 2; ++b)
#pragma unroll
                for (int m = 0; m < 4; ++m)
#pragma unroll
                    for (int n = 0; n < 2; ++n) acc[a][b][m][n] = (f32x4){0.f, 0.f, 0.f, 0.f};
        cur = nxt; cA = nA; cB = nB; ++ui;
        if (wr == 1) PG8_BAR;
    }
    PG8_WAIT_V(0);
    PG8_BAR;
#undef PG8_SA
#undef PG8_SB
#undef PG8_STAGE
#undef PG8_LDA
#undef PG8_LDB
#undef PG8_MMA
#undef PG8_WAIT_V
#undef PG8_WAIT_L
#undef PG8_BAR
#undef PG8_SCHED
}
}

namespace att {
constexpr int NW = 8, QBLK = 32, KVBLK = 64;
constexpr float QSCALE = 0.125f * 1.4426950408889634f;
constexpr int SHM_V = KVBLK * 128 * 2, SHM_K = KVBLK * 64 * 2, NBUF = 4;
#define KSWZ64(row, colB) ((row) * 128 + ((colB) ^ ((((row) >> 1) & 7) << 4)))
#define SBAR() __builtin_amdgcn_sched_barrier(0)
__device__ __forceinline__ int crow(int r, int hi) { return (r & 3) + 8 * (r >> 2) + 4 * hi; }
#define PK4(P, BASE, OUT) do { unsigned a0 = cvt_pk_bf16(P[BASE + 0], P[BASE + 1]), a1 = cvt_pk_bf16(P[BASE + 2], P[BASE + 3]);   \
    unsigned b0 = cvt_pk_bf16(P[BASE + 4], P[BASE + 5]), b1 = cvt_pk_bf16(P[BASE + 6], P[BASE + 7]);                              \
    auto r0 = __builtin_amdgcn_permlane32_swap(a0, b0, false, false); auto r1 = __builtin_amdgcn_permlane32_swap(a1, b1, false, false); \
    u32x4 w = {r0[0], r1[0], r0[1], r1[1]}; OUT = *reinterpret_cast<bf16x8*>(&w); } while (0)
__device__ __forceinline__ void partialSM(f32x16& p0, float& l_reg, bf16x8& pa0, bf16x8& pa1) {
#pragma unroll
    for (int r = 0; r < 16; ++r) p0[r] = __builtin_amdgcn_exp2f(p0[r]);
    float ps = 0;
#pragma unroll
    for (int r = 0; r < 16; ++r) ps += p0[r];
    l_reg += ps;
    PK4(p0, 0, pa0); PK4(p0, 8, pa1);
}
__device__ __forceinline__ void finishSM(f32x16& p1, float& l_reg, bf16x8& pa2, bf16x8& pa3) {
#pragma unroll
    for (int r = 0; r < 16; ++r) p1[r] = __builtin_amdgcn_exp2f(p1[r]);
    float ps = 0;
#pragma unroll
    for (int r = 0; r < 16; ++r) ps += p1[r];
    l_reg += ps;
    PK4(p1, 0, pa2); PK4(p1, 8, pa3);
}
#undef PK4
__device__ __forceinline__ void qkt(f32x16& p0, f32x16& p1, const char* Ks, const bf16x8* qr, const f32x16& negm, int r32, int hi) {
#pragma unroll
    for (int d0 = 0; d0 < 4; ++d0) { const int cb = d0 * 32 + hi * 16;
        bf16x8 b0 = *reinterpret_cast<const bf16x8*>(Ks + KSWZ64(r32, cb));
        bf16x8 b1 = *reinterpret_cast<const bf16x8*>(Ks + KSWZ64(32 + r32, cb));
        if (d0 == 0) { p0 = __builtin_amdgcn_mfma_f32_32x32x16_bf16(b0, qr[0], negm, 0, 0, 0); p1 = __builtin_amdgcn_mfma_f32_32x32x16_bf16(b1, qr[0], negm, 0, 0, 0); }
        else { p0 = __builtin_amdgcn_mfma_f32_32x32x16_bf16(b0, qr[d0], p0, 0, 0, 0); p1 = __builtin_amdgcn_mfma_f32_32x32x16_bf16(b1, qr[d0], p1, 0, 0, 0); } }
}
__device__ __forceinline__ int v_st(int k, int c) { const int kk = (k & ~0xC) | ((k & 4) << 1) | ((k & 8) >> 1); return ((kk >> 3) * 4 + (c >> 5)) * 512 + ((kk & 7) * 32 + (c & 31)) * 2; }
__device__ __forceinline__ int v_rd_base(int lane) { return ((lane & 3) << 3) | (((lane >> 2) & 3) << 6) | (((lane >> 4) & 1) << 5) | (((lane >> 5) & 1) << 8); }
constexpr int v_rd_off(int d0, int ks, int half) { return d0 * 512 + ks * 4096 + half * 2048; }
template <int OFF> __device__ __forceinline__ s16x4 tr_read(int vb) {
    s16x4 r; asm volatile("ds_read_b64_tr_b16 %0, %1 offset:%2" : "=&v"(r) : "v"(vb), "i"(OFF) : "memory"); return r;
}
template <int D0> __device__ __forceinline__ void pv_one(f32x16& od, int vb, bf16x8 pa0, bf16x8 pa1, bf16x8 pa2, bf16x8 pa3) {
    const s16x4 l0 = tr_read<v_rd_off(D0, 0, 0)>(vb), h0 = tr_read<v_rd_off(D0, 0, 1)>(vb), l1 = tr_read<v_rd_off(D0, 1, 0)>(vb), h1 = tr_read<v_rd_off(D0, 1, 1)>(vb);
    const s16x4 l2 = tr_read<v_rd_off(D0, 2, 0)>(vb), h2 = tr_read<v_rd_off(D0, 2, 1)>(vb), l3 = tr_read<v_rd_off(D0, 3, 0)>(vb), h3 = tr_read<v_rd_off(D0, 3, 1)>(vb);
    asm volatile("s_waitcnt lgkmcnt(0)" ::: "memory"); SBAR();
#define PK(L, H) (bf16x8){L[0], L[1], L[2], L[3], H[0], H[1], H[2], H[3]}
    od = __builtin_amdgcn_mfma_f32_32x32x16_bf16(pa0, PK(l0, h0), od, 0, 0, 0);
    od = __builtin_amdgcn_mfma_f32_32x32x16_bf16(pa1, PK(l1, h1), od, 0, 0, 0);
    od = __builtin_amdgcn_mfma_f32_32x32x16_bf16(pa2, PK(l2, h2), od, 0, 0, 0);
    od = __builtin_amdgcn_mfma_f32_32x32x16_bf16(pa3, PK(l3, h3), od, 0, 0, 0);
#undef PK
}
__device__ __forceinline__ void pv_d0(f32x16* o, int vb, bf16x8 pa0, bf16x8 pa1, bf16x8 pa2, bf16x8 pa3) {
    pv_one<0>(o[0], vb, pa0, pa1, pa2, pa3); pv_one<1>(o[1], vb, pa0, pa1, pa2, pa3); pv_one<2>(o[2], vb, pa0, pa1, pa2, pa3); pv_one<3>(o[3], vb, pa0, pa1, pa2, pa3);
}
#define PKF(L, H) (bf16x8){L[0], L[1], L[2], L[3], H[0], H[1], H[2], H[3]}
template <int I, bool EXPS> __device__ __forceinline__ void pv_roll_step(f32x16* o, int vb, const bf16x8& pa0, const bf16x8& pa1, const bf16x8& pa2, const bf16x8& pa3, s16x4 (&L)[4], s16x4 (&H)[4], f32x16& c0, float& ps, unsigned (&cv)[4], bf16x8& ca0) {
    constexpr int ks = I >> 2, d0 = I & 3, sl = I & 3, rem = 15 - I, n = 2 * (rem < 3 ? rem : 3);
    asm volatile("s_waitcnt lgkmcnt(%0)" :: "n"(n) : "memory"); SBAR();
    o[d0] = __builtin_amdgcn_mfma_f32_32x32x16_bf16(ks == 0 ? pa0 : ks == 1 ? pa1 : ks == 2 ? pa2 : pa3, PKF(L[sl], H[sl]), o[d0], 0, 0, 0);
    if constexpr (EXPS) { c0[I] = __builtin_amdgcn_exp2f(c0[I]); if constexpr (I >= 1) ps += c0[I - 1];
        if constexpr (I == 9) { cv[0] = cvt_pk_bf16(c0[0], c0[1]); cv[1] = cvt_pk_bf16(c0[2], c0[3]); cv[2] = cvt_pk_bf16(c0[4], c0[5]); cv[3] = cvt_pk_bf16(c0[6], c0[7]); }
        if constexpr (I == 10) { auto r0 = __builtin_amdgcn_permlane32_swap(cv[0], cv[2], false, false); auto r1 = __builtin_amdgcn_permlane32_swap(cv[1], cv[3], false, false);
            u32x4 w = {r0[0], r1[0], r0[1], r1[1]}; ca0 = *reinterpret_cast<bf16x8*>(&w); } }
    if constexpr (I + 4 < 16) { SBAR(); L[sl] = tr_read<v_rd_off((I + 4) & 3, (I + 4) >> 2, 0)>(vb); H[sl] = tr_read<v_rd_off((I + 4) & 3, (I + 4) >> 2, 1)>(vb); }
}
__device__ __forceinline__ void pv_window0(int vb, s16x4 (&L)[4], s16x4 (&H)[4]) {
    L[0] = tr_read<v_rd_off(0, 0, 0)>(vb); H[0] = tr_read<v_rd_off(0, 0, 1)>(vb); L[1] = tr_read<v_rd_off(1, 0, 0)>(vb); H[1] = tr_read<v_rd_off(1, 0, 1)>(vb);
    L[2] = tr_read<v_rd_off(2, 0, 0)>(vb); H[2] = tr_read<v_rd_off(2, 0, 1)>(vb); L[3] = tr_read<v_rd_off(3, 0, 0)>(vb); H[3] = tr_read<v_rd_off(3, 0, 1)>(vb);
}
template <bool EXPS> __device__ __forceinline__ void pv_roll(f32x16* o, int vb, const bf16x8& pa0, const bf16x8& pa1, const bf16x8& pa2, const bf16x8& pa3, s16x4 (&L)[4], s16x4 (&H)[4], f32x16& c0, float& l_reg, bf16x8& ca0, bf16x8& ca1) {
    float ps = 0.f; unsigned cv[4] = {0u, 0u, 0u, 0u};
    pv_roll_step<0, EXPS>(o, vb, pa0, pa1, pa2, pa3, L, H, c0, ps, cv, ca0);   pv_roll_step<1, EXPS>(o, vb, pa0, pa1, pa2, pa3, L, H, c0, ps, cv, ca0);   pv_roll_step<2, EXPS>(o, vb, pa0, pa1, pa2, pa3, L, H, c0, ps, cv, ca0);   pv_roll_step<3, EXPS>(o, vb, pa0, pa1, pa2, pa3, L, H, c0, ps, cv, ca0);
    pv_roll_step<4, EXPS>(o, vb, pa0, pa1, pa2, pa3, L, H, c0, ps, cv, ca0);   pv_roll_step<5, EXPS>(o, vb, pa0, pa1, pa2, pa3, L, H, c0, ps, cv, ca0);   pv_roll_step<6, EXPS>(o, vb, pa0, pa1, pa2, pa3, L, H, c0, ps, cv, ca0);   pv_roll_step<7, EXPS>(o, vb, pa0, pa1, pa2, pa3, L, H, c0, ps, cv, ca0);
    pv_roll_step<8, EXPS>(o, vb, pa0, pa1, pa2, pa3, L, H, c0, ps, cv, ca0);   pv_roll_step<9, EXPS>(o, vb, pa0, pa1, pa2, pa3, L, H, c0, ps, cv, ca0);   pv_roll_step<10, EXPS>(o, vb, pa0, pa1, pa2, pa3, L, H, c0, ps, cv, ca0);  pv_roll_step<11, EXPS>(o, vb, pa0, pa1, pa2, pa3, L, H, c0, ps, cv, ca0);
    pv_roll_step<12, EXPS>(o, vb, pa0, pa1, pa2, pa3, L, H, c0, ps, cv, ca0);  pv_roll_step<13, EXPS>(o, vb, pa0, pa1, pa2, pa3, L, H, c0, ps, cv, ca0);  pv_roll_step<14, EXPS>(o, vb, pa0, pa1, pa2, pa3, L, H, c0, ps, cv, ca0);  pv_roll_step<15, EXPS>(o, vb, pa0, pa1, pa2, pa3, L, H, c0, ps, cv, ca0);
    SBAR();
    if constexpr (EXPS) { ps += c0[15]; l_reg += ps;
        unsigned a0 = cvt_pk_bf16(c0[8], c0[9]), a1 = cvt_pk_bf16(c0[10], c0[11]), b0 = cvt_pk_bf16(c0[12], c0[13]), b1 = cvt_pk_bf16(c0[14], c0[15]);
        auto r0 = __builtin_amdgcn_permlane32_swap(a0, b0, false, false); auto r1 = __builtin_amdgcn_permlane32_swap(a1, b1, false, false);
        u32x4 w = {r0[0], r1[0], r0[1], r1[1]}; ca1 = *reinterpret_cast<bf16x8*>(&w); }
}
__device__ __forceinline__ void partialSM_tail(f32x16& p0, float& l_reg, bf16x8& pa0, bf16x8& pa1) {
    float ps = 0;
#pragma unroll
    for (int r = 0; r < 16; ++r) ps += p0[r];
    l_reg += ps;
#define PK4(P, BASE, OUT) do { unsigned a0 = cvt_pk_bf16(P[BASE + 0], P[BASE + 1]), a1 = cvt_pk_bf16(P[BASE + 2], P[BASE + 3]);   \
    unsigned b0 = cvt_pk_bf16(P[BASE + 4], P[BASE + 5]), b1 = cvt_pk_bf16(P[BASE + 6], P[BASE + 7]);                              \
    auto r0 = __builtin_amdgcn_permlane32_swap(a0, b0, false, false); auto r1 = __builtin_amdgcn_permlane32_swap(a1, b1, false, false); \
    u32x4 w = {r0[0], r1[0], r0[1], r1[1]}; OUT = *reinterpret_cast<bf16x8*>(&w); } while (0)
    PK4(p0, 0, pa0); PK4(p0, 8, pa1);
#undef PK4
}
#undef PKF
template <bool SECOND>
__device__ __forceinline__ void attn_unit(const bf16_t* __restrict__ Qb, const bf16_t* __restrict__ Kh, const bf16_t* __restrict__ Vh, bf16_t* O1, bf16_t* Hd, float lam, const float* subln, int seq, float KN, char* lds, LAS unsigned char* ldsl, const int wave_s, const float* qnw, const float* rope, const int t0) {
    int tid = wave_s * 64 + lane_id_opaque(); asm volatile("" : "+v"(tid));
    const int wid = __builtin_amdgcn_readfirstlane(tid >> 6), lane = tid & 63, r32 = lane & 31, hi = lane >> 5;
    constexpr int KOFF = NBUF * SHM_V;
    char* V_lds = lds; char* K_lds = lds + KOFF;
    float* ws = (float*)(lds + NBUF * SHM_V + NBUF * SHM_K) + wid * 64; float* li_l = ws;
    float l_reg = 0; f32x16 o[4] = {}; bf16x8 qr[4];
    const bf16_t* Qw = Qb + (long)(wid * QBLK + r32) * LDQKV + hi * 8;
#pragma unroll
    for (int d0 = 0; d0 < 4; ++d0) qr[d0] = *reinterpret_cast<const bf16x8*>(Qw + d0 * 16);
    { float y[4][8]; float ss = 0.f;
#pragma unroll
      for (int d0 = 0; d0 < 4; ++d0)
#pragma unroll
          for (int e = 0; e < 8; ++e) { y[d0][e] = __uint_as_float(((unsigned)(unsigned short)qr[d0][e]) << 16); ss += y[d0][e] * y[d0][e]; }
      { auto rr = __builtin_amdgcn_permlane32_swap(__float_as_uint(ss), __float_as_uint(ss), false, false); ss = __uint_as_float(rr[0]) + __uint_as_float(rr[1]); }
      const float rstd = rsqrtf(ss * (1.f / 64.f) + EPS);
#pragma unroll
      for (int d0 = 0; d0 < 4; ++d0) { const f32x4 w0 = *(const f32x4*)(qnw + d0 * 16 + hi * 8), w1 = *(const f32x4*)(qnw + d0 * 16 + hi * 8 + 4);
#pragma unroll
          for (int e = 0; e < 4; ++e) { y[d0][e] *= rstd * w0[e]; y[d0][e + 4] *= rstd * w1[e]; } }
      const int t = t0 + wid * QBLK + r32;
      const float* tr = rope + (t >> 6) * 32 + hi * 16; const float* tc = rope + (t & 63) * 32 + hi * 16;
#pragma unroll
      for (int e = 0; e < 8; ++e) { const float cr = tr[2 * e], sr = tr[2 * e + 1], cc = tc[2 * e], sc = tc[2 * e + 1];
          const float a = y[0][e], b = y[1][e], c = y[2][e], d = y[3][e];
          y[0][e] = a * cr - b * sr; y[1][e] = a * sr + b * cr; y[2][e] = c * cc - d * sc; y[3][e] = c * sc + d * cc; }
#pragma unroll
      for (int d0 = 0; d0 < 4; ++d0) { u32x4 w; w.x = cvt_pk_bf16(y[d0][0] * QSCALE, y[d0][1] * QSCALE); w.y = cvt_pk_bf16(y[d0][2] * QSCALE, y[d0][3] * QSCALE);
          w.z = cvt_pk_bf16(y[d0][4] * QSCALE, y[d0][5] * QSCALE); w.w = cvt_pk_bf16(y[d0][6] * QSCALE, y[d0][7] * QSCALE); qr[d0] = *reinterpret_cast<bf16x8*>(&w); } }
    unsigned kgo, vgo0, vgo1;
    { const int row = wid * 8 + (lane >> 3), colB = ((lane & 7) * 16) ^ (((row >> 1) & 7) << 4);
      kgo = (unsigned)(row * LDQKV * 2 + colB);
      const int st0 = wid * 2 + (lane >> 5), st1 = 16 + st0, klo = (lane & 31) >> 2, cl = (lane & 3) * 8;
      const int kk0 = (st0 >> 2) * 8 + klo, kk1 = (st1 >> 2) * 8 + klo;
      const int k0 = (kk0 & ~0xC) | ((kk0 & 4) << 1) | ((kk0 & 8) >> 1), k1 = (kk1 & ~0xC) | ((kk1 & 4) << 1) | ((kk1 & 8) >> 1);
      const unsigned dv = (unsigned)((const char*)Vh - (const char*)Kh);
      vgo0 = dv + (unsigned)((k0 * LDQKV + (st0 & 3) * 32 + cl) * 2); vgo1 = dv + (unsigned)((k1 * LDQKV + (st1 & 3) * 32 + cl) * 2); }
#define DMA(t, slot) do { const char* gb_ = (const char*)Kh + (size_t)(t) * (KVBLK * LDQKV * 2); \
    __builtin_amdgcn_global_load_lds((const unsigned*)(gb_ + kgo), (LAS unsigned*)(ldsl + KOFF + (slot) * SHM_K + wid * 1024), 16, 0, 0); \
    __builtin_amdgcn_global_load_lds((const unsigned*)(gb_ + vgo0), (LAS unsigned*)(ldsl + (slot) * SHM_V + wid * 1024), 16, 0, 0); \
    __builtin_amdgcn_global_load_lds((const unsigned*)(gb_ + vgo1), (LAS unsigned*)(ldsl + (slot) * SHM_V + 8192 + wid * 1024), 16, 0, 0); } while (0)
#define WAIT_BAR(N) asm volatile("s_waitcnt vmcnt(" #N ") lgkmcnt(0)\n\ts_barrier" ::: "memory")
    DMA(0, 0); DMA(1, 1);
    f32x16 negm;
    { float ss = 0.f;
#pragma unroll
      for (int d0 = 0; d0 < 4; ++d0)
#pragma unroll
          for (int e = 0; e < 8; ++e) { const float v = __uint_as_float(((unsigned)(unsigned short)qr[d0][e]) << 16); ss += v * v; }
      auto rr = __builtin_amdgcn_permlane32_swap(__float_as_uint(ss), __float_as_uint(ss), false, false);
      ss = __uint_as_float(rr[0]) + __uint_as_float(rr[1]);
      const float nb = -sqrtf(ss) * KN;
#pragma unroll
      for (int r = 0; r < 16; ++r) negm[r] = nb; }
    const int vb0 = (int)(uintptr_t)V_lds + v_rd_base(lane);
    f32x16 pA0, pA1, pB0, pB1; bf16x8 paA0, paA1, paB0, paB1, pa2, pa3; const int NT = seq / KVBLK;
    const bool grpB = false;
    WAIT_BAR(3);
    DMA(2, 2);
    qkt(pA0, pA1, K_lds, qr, negm, r32, hi); partialSM(pA0, l_reg, paA0, paA1);
    WAIT_BAR(3);
    if (grpB) WAIT_BAR(3);
#define STEP(j, C0, C1, CA0, CA1, P1, PA0, PA1) do { \
        if ((j) + 2 < NT) DMA((j) + 2, ((j) + 2) & 3); \
        const int vb_ = vb0 + (((j) - 1) & 3) * SHM_V; \
        SBAR(); pv_window0(vb_, VL, VH); SBAR(); \
        qkt(C0, C1, K_lds + ((j) & 3) * SHM_K, qr, negm, r32, hi); \
        finishSM(P1, l_reg, pa2, pa3); SBAR(); \
        pv_roll<true>(o, vb_, PA0, PA1, pa2, pa3, VL, VH, C0, l_reg, CA0, CA1); SBAR(); \
        if ((j) + 2 < NT) WAIT_BAR(3); else WAIT_BAR(0); } while (0)
    s16x4 VL[4], VH[4];
    for (int j = 1; j + 1 < NT; j += 2) {
        STEP(j, pB0, pB1, paB0, paB1, pA1, paA0, paA1);
        STEP(j + 1, pA0, pA1, paA0, paA1, pB1, paB0, paB1);
    }
    STEP(NT - 1, pB0, pB1, paB0, paB1, pA1, paA0, paA1);
    finishSM(pB1, l_reg, pa2, pa3); SBAR();
    pv_window0(vb0 + ((NT - 1) & 3) * SHM_V, VL, VH);
    pv_roll<false>(o, vb0 + ((NT - 1) & 3) * SHM_V, paB0, paB1, pa2, pa3, VL, VH, pB0, l_reg, paB0, paB1);
    if (!grpB) WAIT_BAR(0);
#undef STEP
    { auto rr = __builtin_amdgcn_permlane32_swap(__float_as_uint(l_reg), __float_as_uint(l_reg), false, false); l_reg = __uint_as_float(rr[0]) + __uint_as_float(rr[1]); }
    if (hi == 0) li_l[r32] = l_reg; asm volatile("s_waitcnt lgkmcnt(0)" ::: "memory");
    float rli[16];
#pragma unroll
    for (int r = 0; r < 16; ++r) rli[r] = __builtin_amdgcn_rcpf(li_l[crow(r, hi)]);
#define ROWWALK(PTR, r) do { PTR += ((r) & 3) == 3 ? 5 * 1024 : 1024; asm volatile("" : "+v"(PTR)); } while (0)
    const long lane_off = (long)(wid * QBLK + 4 * hi) * 1024 + r32;
    if constexpr (!SECOND) {
        bf16_t* pw = O1 + lane_off; asm volatile("" : "+v"(pw));
#pragma unroll
        for (int r = 0; r < 16; ++r) {
#pragma unroll
            for (int d0 = 0; d0 < 4; ++d0) pw[d0 * 32] = (bf16_t)(cvt_pk_bf16(o[d0][r] * rli[r], 0.f) & 0xffffu);
            ROWWALK(pw, r); }
    } else {
        float sw[4];
#pragma unroll
        for (int d0 = 0; d0 < 4; ++d0) sw[d0] = subln[d0 * 32 + r32] * 0.8f;
        const bf16_t* pr = O1 + lane_off; asm volatile("" : "+v"(pr));
        float ssr[16];
#pragma unroll
        for (int r = 0; r < 16; ++r) { float sq = 0.f;
#pragma unroll
            for (int d0 = 0; d0 < 4; ++d0) { const float o1v = __uint_as_float(((unsigned)pr[d0 * 32]) << 16);
                const float y = o1v - lam * (o[d0][r] * rli[r]); o[d0][r] = y; sq += y * y; }
            ssr[r] = sq; ROWWALK(pr, r); }
#pragma unroll
        for (int m = 1; m < 32; m <<= 1)
#pragma unroll
            for (int r = 0; r < 16; ++r) ssr[r] += __shfl_xor(ssr[r], m);
        bf16_t* pw = Hd + lane_off; asm volatile("" : "+v"(pw));
#pragma unroll
        for (int r = 0; r < 16; ++r) { const float rstd = rsqrtf(ssr[r] * (1.f / 128.f) + EPS);
#pragma unroll
            for (int d0 = 0; d0 < 4; ++d0) pw[d0 * 32] = (bf16_t)(cvt_pk_bf16(o[d0][r] * rstd * sw[d0], 0.f) & 0xffffu);
            ROWWALK(pw, r); }
    }
#undef ROWWALK
    WAIT_BAR(0);
#undef DMA
#undef WAIT_BAR
}
#undef SBAR
}

struct Args { const float* in[23]; float* out; unsigned char* ws; int lo, hi; };
enum { I_X = 0, I_C, I_CTX, I_CCTX, I_WMOD, I_BMOD, I_NAW, I_WIN, I_QNW, I_KNW, I_LQ1, I_LK1, I_LQ2, I_LK2, I_SUBLN, I_POOLW, I_POOLS, I_WA, I_WB, I_WO, I_NMW, I_FF1, I_FF2 };
constexpr int LDS_BYTES = 131072 + 1024;

__device__ __forceinline__ void p0_transpose_item(const float* W, int K, int N, bf16_t* WT, LAS float* scr, int item, int lane) {
    const int nblk = N / 32, kb = item / nblk, nb = item % nblk, k0 = 64 * kb, n0 = 32 * nb;
#pragma unroll 8
    for (int i = 0; i < 32; ++i) { const int kk = 2 * i + (lane >> 5); scr[kk * 33 + (lane & 31)] = W[(size_t)(k0 + kk) * N + n0 + (lane & 31)]; }
    asm volatile("s_waitcnt lgkmcnt(0)" ::: "memory");
    const int c = lane & 7;
#pragma unroll
    for (int j = 0; j < 4; ++j) { const int n = (lane >> 3) + 8 * j; const LAS float* s = scr + (8 * c) * 33 + n;
        u32x4 o; o.x = cvt_pk_bf16(s[0 * 33], s[1 * 33]); o.y = cvt_pk_bf16(s[2 * 33], s[3 * 33]); o.z = cvt_pk_bf16(s[4 * 33], s[5 * 33]); o.w = cvt_pk_bf16(s[6 * 33], s[7 * 33]);
        *(u32x4*)(WT + (size_t)(n0 + n) * K + k0 + 8 * c) = o; }
    asm volatile("s_waitcnt lgkmcnt(0)" ::: "memory");
}

template <typename XT>
__device__ __forceinline__ void modulate_rows(const XT* X, int nrows, int rpw, const float* nw, const float* mod, int shift_off, int scale_off, int rows_per_batch, bf16_t* out, int gw, int NGW, int lane) {
    for (int m0 = gw * rpw; m0 < nrows; m0 += NGW * rpw) {
        const int r = rows_per_batch ? m0 / rows_per_batch : 4;
        const float* mr = mod + (size_t)r * NMOD;
        for (int mi = 0; mi < rpw; mi += 2) {
            const int m = m0 + mi;
            f32x4 v[2][8];
            if constexpr (sizeof(XT) == 4) {
#pragma unroll
                for (int q = 0; q < 2; ++q) { const f32x4* xr = (const f32x4*)((const float*)X + (size_t)(m + q) * DM) + lane;
#pragma unroll
                    for (int j = 0; j < 8; ++j) v[q][j] = __builtin_nontemporal_load(xr + 64 * j); }
            } else {
                u32x2 w[2][8];
#pragma unroll
                for (int q = 0; q < 2; ++q) { const u32x2* xr = (const u32x2*)((const bf16_t*)X + (size_t)(m + q) * DM) + lane;
#pragma unroll
                    for (int j = 0; j < 8; ++j) w[q][j] = xr[64 * j]; }
#pragma unroll
                for (int q = 0; q < 2; ++q)
#pragma unroll
                    for (int j = 0; j < 8; ++j) v[q][j] = (f32x4){bflo(w[q][j].x), bfhi(w[q][j].x), bflo(w[q][j].y), bfhi(w[q][j].y)};
            }
            float rstd[2];
#pragma unroll
            for (int q = 0; q < 2; ++q) { float ss = 0.f;
#pragma unroll
                for (int j = 0; j < 8; ++j) ss += (v[q][j].x * v[q][j].x + v[q][j].y * v[q][j].y) + (v[q][j].z * v[q][j].z + v[q][j].w * v[q][j].w);
                rstd[q] = rsqrtf(wave_sum(ss) * (1.f / DM) + EPS); }
#pragma unroll
            for (int j = 0; j < 8; ++j) { const int col = (lane + 64 * j) * 4;
                const f32x4 Ac = *(const f32x4*)(nw + col) * (*(const f32x4*)(mr + scale_off + col) + 1.0f), Bc = *(const f32x4*)(mr + shift_off + col);
#pragma unroll
                for (int q = 0; q < 2; ++q) { const f32x4 y = (v[q][j] * rstd[q]) * Ac + Bc;
                    u32x2 o; o.x = cvt_pk_bf16(y.x, y.y); o.y = cvt_pk_bf16(y.z, y.w);
                    *(u32x2*)(out + (size_t)(m + q) * DM + col) = o; } }
        }
    }
}

__device__ __forceinline__ void grid_bar(unsigned* ctr, unsigned k, int tid) {
    asm volatile("s_waitcnt vmcnt(0) lgkmcnt(0)" ::: "memory");
    __syncthreads();
    if (tid == 0) {
        __builtin_amdgcn_fence(__ATOMIC_RELEASE, "agent");
        asm volatile("s_waitcnt vmcnt(0)" ::: "memory");
        const unsigned G = gridDim.x, grp = blockIdx.x >> 5, ngrp = (G + 31u) >> 5, gsz = (grp + 1u) * 32u <= G ? 32u : G - grp * 32u;
        const unsigned old = __hip_atomic_fetch_add(ctr + 64 * (1 + grp), 1u, __ATOMIC_RELAXED, __HIP_MEMORY_SCOPE_AGENT);
        if (old + 1u == k * gsz) __hip_atomic_fetch_add(ctr, 1u, __ATOMIC_RELAXED, __HIP_MEMORY_SCOPE_AGENT);
        while (__hip_atomic_load(ctr, __ATOMIC_RELAXED, __HIP_MEMORY_SCOPE_AGENT) < k * ngrp) __builtin_amdgcn_s_sleep(1);
        __builtin_amdgcn_fence(__ATOMIC_ACQUIRE, "agent");
        asm volatile("s_waitcnt vmcnt(0)" ::: "memory");
    }
    __syncthreads();
}

__global__ void __launch_bounds__(512, 2) fwd_kernel(Args args) {
    extern __shared__ __attribute__((aligned(16))) unsigned char lds[];
    LAS unsigned char* ldsl = (LAS unsigned char*)lds;
    int wave_k = __builtin_amdgcn_readfirstlane((int)threadIdx.x >> 6); asm volatile("" : "+s"(wave_k));
    int lo, hi;
    { const Args __attribute__((address_space(4)))* A0 = (const Args __attribute__((address_space(4)))*)(unsigned long long)__builtin_amdgcn_kernarg_segment_ptr(); lo = A0->lo; hi = A0->hi; }
#define PH_VARS \
    const Args __attribute__((address_space(4)))* A_; { unsigned long long kp_ = (unsigned long long)__builtin_amdgcn_kernarg_segment_ptr(); asm volatile("" : "+s"(kp_)); A_ = (const Args __attribute__((address_space(4)))*)kp_; } \
    int tid = wave_k * 64 + lane_id_opaque(); asm volatile("" : "+v"(tid)); \
    const int lane = tid & 63, wave = __builtin_amdgcn_readfirstlane(tid >> 6); \
    const int G = gridDim.x, bx = blockIdx.x; \
    const int vcu = (G % 8 == 0) ? (bx % 8) * (G / 8) + bx / 8 : bx; \
    const int gw = vcu * 8 + wave, NGW = G * 8; \
    unsigned char* ws = A_->ws; \
    float* mod = (float*)(ws + WS_MOD); float* rope = (float*)(ws + WS_ROPE); \
    bf16_t* Win_t = (bf16_t*)(ws + WS_WIN); bf16_t* Wff1_t = (bf16_t*)(ws + WS_WFF1); bf16_t* Wff2_t = (bf16_t*)(ws + WS_WFF2); bf16_t* Wo_t = (bf16_t*)(ws + WS_WO); \
    bf16_t* Wa_t = (bf16_t*)(ws + WS_WA); bf16_t* Wb_t = (bf16_t*)(ws + WS_WB); bf16_t* Wp_t = (bf16_t*)(ws + WS_WP); \
    bf16_t* Hb = (bf16_t*)(ws + WS_H); bf16_t* HCb = (bf16_t*)(ws + WS_HC); bf16_t* QKV = (bf16_t*)(ws + WS_QKV); bf16_t* PG = (bf16_t*)(ws + WS_PG); \
    bf16_t* Db = (bf16_t*)(ws + WS_D); bf16_t* POOLED = (bf16_t*)(ws + WS_POOLED); bf16_t* OSUB = (bf16_t*)(ws + WS_OSUB); \
    bf16_t* HEADS = (bf16_t*)(ws + WS_HEADS); bf16_t* X1 = (bf16_t*)(ws + WS_X1); (void)X1; bf16_t* Mb = (bf16_t*)(ws + WS_M); bf16_t* H2 = (bf16_t*)(ws + WS_H2); bf16_t* Ub = (bf16_t*)(ws + WS_U); \
    (void)lane; (void)wave; (void)gw; (void)NGW; (void)mod; (void)rope; (void)Win_t; (void)Wff1_t; (void)Wff2_t; (void)Wo_t; (void)Wa_t; (void)Wb_t; (void)Wp_t; (void)Hb; (void)HCb; (void)QKV; (void)PG; \
    (void)Db; (void)POOLED; (void)OSUB; (void)HEADS; (void)Mb; (void)H2; (void)Ub; (void)bx; (void)vcu;
#ifndef PH_MASK
#define PH_MASK 0x3ff
#endif
#define IN(k) (((PH_MASK >> (k)) & 1) && lo <= (k) && (k) < hi)
#define SEAM(k) do { if (IN(k) && IN((k) + 1)) { if ((k) == 0) { cg::this_grid().sync(); } else { \
        const Args __attribute__((address_space(4)))* Ab_ = (const Args __attribute__((address_space(4)))*)(unsigned long long)__builtin_amdgcn_kernarg_segment_ptr(); \
        grid_bar((unsigned*)(Ab_->ws + WS_BAR), (unsigned)(k), wave_k * 64 + lane_id_opaque()); } } } while (0)

    if (IN(0)) { PH_VARS;
        {
            float* sc = (float*)lds;
            const float* c = A_->in[I_C]; const float* cc = A_->in[I_CCTX];
            for (int i = tid; i < 5 * DM; i += 512) { const int r = i / DM, k = i % DM; const float v = (r < 4) ? c[r * DM + k] : cc[k]; sc[i] = v / (1.0f + __expf(-v)); }
            __syncthreads();
            const float* wm = A_->in[I_WMOD]; const float* bm = A_->in[I_BMOD];
            float* red = (float*)(lds + 40960);
            for (int cb = bx; cb < NMOD / 48; cb += G) {
                const int col0 = cb * 48;
                if (tid < 504) {
                    const int cgp = tid % 12, ks = tid / 12;
                    float a[5][4];
#pragma unroll
                    for (int r = 0; r < 5; ++r)
#pragma unroll
                        for (int j = 0; j < 4; ++j) a[r][j] = 0.f;
                    for (int k = ks; k < DM; k += 42) {
                        const f32x4 w = *(const f32x4*)(wm + (size_t)k * NMOD + col0 + cgp * 4);
#pragma unroll
                        for (int r = 0; r < 5; ++r) { const float s = sc[r * DM + k]; a[r][0] += s * w.x; a[r][1] += s * w.y; a[r][2] += s * w.z; a[r][3] += s * w.w; }
                    }
#pragma unroll
                    for (int r = 0; r < 5; ++r)
#pragma unroll
                        for (int j = 0; j < 4; ++j) red[(r * 4 + j) * 504 + tid] = a[r][j];
                }
                __syncthreads();
                if (tid < 240) { const int r = tid / 48, ccol = tid % 48, cgp = ccol / 4, j = ccol % 4; float s = 0.f;
                    for (int ks = 0; ks < 42; ++ks) s += red[(r * 4 + j) * 504 + ks * 12 + cgp];
                    mod[r * NMOD + col0 + ccol] = s + bm[col0 + ccol]; }
                __syncthreads();
            }
            if (bx == 0 && tid <= 16) __hip_atomic_store((unsigned*)(ws + WS_BAR) + 64 * tid, 0u, __ATOMIC_RELAXED, __HIP_MEMORY_SCOPE_AGENT);
            if (bx == 0) for (int i = tid; i < 128 * 16; i += 512) { const int pos = i >> 4, f = i & 15;
                const float inv = powf(10000.0f, -(float)(2 * f) / 32.0f); float sn, cs; sincosf((float)pos * inv, &sn, &cs); rope[2 * i] = cs; rope[2 * i + 1] = sn; }
            __syncthreads();
        }
        LAS float* scr = (LAS float*)(ldsl + wave * 16384);
        constexpr int I_IN = (DM / 64) * (INW / 32), I_F1 = (DM / 64) * (DFF / 32), I_F2 = (DFF / 64) * (DM / 32), I_O = (DM / 64) * (DM / 32), I_A = (1024 / 64) * (DM / 32), I_P = 4 * 8;
        constexpr int NITEMS = I_IN + I_F1 + I_F2 + I_O + 2 * I_A + 4 * I_P;
        for (int it = gw; it < NITEMS; it += NGW) {
            int r = it;
            if (r < I_IN) { p0_transpose_item(A_->in[I_WIN], DM, INW, Win_t, scr, r, lane); continue; } r -= I_IN;
            if (r < I_F1) { p0_transpose_item(A_->in[I_FF1], DM, DFF, Wff1_t, scr, r, lane); continue; } r -= I_F1;
            if (r < I_F2) { p0_transpose_item(A_->in[I_FF2], DFF, DM, Wff2_t, scr, r, lane); continue; } r -= I_F2;
            if (r < I_O) { p0_transpose_item(A_->in[I_WO], DM, DM, Wo_t, scr, r, lane); continue; } r -= I_O;
            if (r < I_A) { p0_transpose_item(A_->in[I_WA], 1024, DM, Wa_t, scr, r, lane); continue; } r -= I_A;
            if (r < I_A) { p0_transpose_item(A_->in[I_WB], 1024, DM, Wb_t, scr, r, lane); continue; } r -= I_A;
            const int gq = r / I_P; r -= gq * I_P;
            p0_transpose_item(A_->in[I_POOLW] + (size_t)gq * 65536, 256, 256, Wp_t + (size_t)gq * 65536, scr, r, lane);
        }
    }
    SEAM(0);
    if (IN(1)) { PH_VARS;
        modulate_rows<float>(A_->in[I_X], MTOK, 16, A_->in[I_NAW], mod, 0, DM, SEQ, Hb, gw, NGW, lane);
        modulate_rows<float>(A_->in[I_CTX], NB * CTX, 4, A_->in[I_NAW], mod, 0, DM, 0, HCb, gw, NGW, lane);
    }
    SEAM(1);
    if (IN(2)) { PH_VARS;
        { pg8::Gemm g{Hb, Win_t, MTOK, INW, DM, DM, DM, 0, 128, 128}; pg8::StaticOrder S; S.init(MTOK, INW, G, bx);
          pg8::Epi<pg8::E_G1> E{QKV, PG, nullptr, nullptr, nullptr, nullptr};
          pg8::gemm_phase(tid, ldsl, g, S, E); }
        { pg8::Gemm g{HCb, Win_t + (size_t)1024 * DM, NB * CTX, 2048, DM, DM, DM, 0, 128, 128}; pg8::StaticOrder S; S.init(NB * CTX, 2048, G, bx);
          pg8::Epi<pg8::E_CTX> E{QKV, nullptr, nullptr, nullptr, nullptr, nullptr};
          pg8::gemm_phase(tid, ldsl, g, S, E); }
    }
    SEAM(2);
    if (IN(3)) { PH_VARS;
        const float* qnw = A_->in[I_QNW]; const float* knw = A_->in[I_KNW];
        for (int R = gw; R < MKV; R += NGW) {
            const int t = R % SKV; const bool isc = t >= SEQ;
            const int head = lane >> 1, half = lane & 1;
            bf16_t* p = QKV + (size_t)R * LDQKV + head * 64 + half * 32;
            float y[32];
            { u32x4 a = {0u, 0u, 0u, 0u}, b = a, c = a, d = a;
              if (head >= 16) { a = *(const u32x4*)p; b = *(const u32x4*)(p + 8); c = *(const u32x4*)(p + 16); d = *(const u32x4*)(p + 24); }
              const unsigned w[16] = {a.x, a.y, a.z, a.w, b.x, b.y, b.z, b.w, c.x, c.y, c.z, c.w, d.x, d.y, d.z, d.w};
#pragma unroll
              for (int i = 0; i < 16; ++i) { y[2 * i] = bflo(w[i]); y[2 * i + 1] = bfhi(w[i]); } }
            float ss = 0.f;
#pragma unroll
            for (int i = 0; i < 32; ++i) ss += y[i] * y[i];
            ss += __shfl_xor(ss, 1);
            const float rstd = rsqrtf(ss * (1.f / 64.f) + EPS);
            const float* nw = (head < 16 ? qnw : knw) + half * 32;
#pragma unroll
            for (int i = 0; i < 32; ++i) y[i] = y[i] * rstd * nw[i];
            if (!isc) {
                const int pos = half ? (t & 63) : (t >> 6);
                const float* tb = rope + pos * 32;
#pragma unroll
                for (int i = 0; i < 16; ++i) { const float cs = tb[2 * i], sn = tb[2 * i + 1], a = y[i], b = y[i + 16]; y[i] = a * cs - b * sn; y[i + 16] = a * sn + b * cs; }
            }
            if (head >= 16) {
                u32x4 o[4];
#pragma unroll
                for (int q = 0; q < 4; ++q) { o[q].x = cvt_pk_bf16(y[8 * q], y[8 * q + 1]); o[q].y = cvt_pk_bf16(y[8 * q + 2], y[8 * q + 3]); o[q].z = cvt_pk_bf16(y[8 * q + 4], y[8 * q + 5]); o[q].w = cvt_pk_bf16(y[8 * q + 6], y[8 * q + 7]); }
                *(u32x4*)p = o[0]; *(u32x4*)(p + 8) = o[1]; *(u32x4*)(p + 16) = o[2]; *(u32x4*)(p + 24) = o[3];
            }
        }
        for (long it = (long)vcu * 512 + tid; it < (long)MTOK * 128; it += (long)G * 512) {
            const int row = (int)(it >> 7), ch = (int)(it & 127), gq = ch >> 5, w = 2 << gq;
            const int t = row & (SEQ - 1), rb = row - t;
            const int l0 = max(t - w / 2, 0), h0 = min(t + w - w / 2, SEQ);
            float s[8];
#pragma unroll
            for (int i = 0; i < 8; ++i) s[i] = 0.f;
            for (int tt = l0; tt < h0; ++tt) { const u32x4 a = *(const u32x4*)(PG + (size_t)(rb + tt) * LDPG + ch * 8);
                s[0] += bflo(a.x); s[1] += bfhi(a.x); s[2] += bflo(a.y); s[3] += bfhi(a.y); s[4] += bflo(a.z); s[5] += bfhi(a.z); s[6] += bflo(a.w); s[7] += bfhi(a.w); }
            const float inv = 1.0f / (float)(h0 - l0);
            const u32x4 a = *(const u32x4*)(PG + (size_t)row * LDPG + ch * 8);
            u32x4 o; o.x = cvt_pk_bf16(s[0] * inv - bflo(a.x), s[1] * inv - bfhi(a.x)); o.y = cvt_pk_bf16(s[2] * inv - bflo(a.y), s[3] * inv - bfhi(a.y));
            o.z = cvt_pk_bf16(s[4] * inv - bflo(a.z), s[5] * inv - bfhi(a.z)); o.w = cvt_pk_bf16(s[6] * inv - bflo(a.w), s[7] * inv - bfhi(a.w));
            *(u32x4*)(Db + (size_t)row * 1024 + ch * 8) = o;
        }
    }
    SEAM(3);
    if (IN(4)) { PH_VARS;
        { pg8::Gemm g{Db, Wp_t, MTOK, 1024, 256, 1024, 256, 256, 128, 128}; pg8::StaticOrder S; S.init(MTOK, 1024, G, bx);
          pg8::Epi<pg8::E_POOL> E{POOLED, nullptr, nullptr, nullptr, A_->in[I_POOLS], nullptr};
          pg8::gemm_phase(tid, ldsl, g, S, E); }
        __syncthreads();
    }
    if (IN(4)) { PH_VARS;
        float KN; { float w = fabsf(A_->in[I_KNW][lane]);
#pragma unroll
            for (int o = 1; o < 64; o <<= 1) w = fmaxf(w, __shfl_xor(w, o));
            KN = 8.0f * w * 1.01f; }
        const float l1 = wave_sum(A_->in[I_LQ1][lane] * A_->in[I_LK1][lane]), l2 = wave_sum(A_->in[I_LQ2][lane] * A_->in[I_LK2][lane]);
        const float lam_init = 0.2f, lam = __expf(l1) - __expf(l2) + lam_init;
        const float* subln = A_->in[I_SUBLN];
        for (int U = vcu; U < NB * 8 * (SEQ / 256); U += G) {
            const int bh = U >> 5, qb = U & 31, b = bh >> 3, h = bh & 7;
            const bf16_t* base = QKV + (size_t)b * SKV * LDQKV;
            const bf16_t* qp = base + (size_t)qb * 256 * LDQKV + h * 128; const bf16_t* kp = base + 1024 + h * 128; const bf16_t* vp = base + 2048 + h * 128;
            bf16_t* o1 = OSUB + (size_t)(b * SEQ + qb * 256) * 1024 + h * 128; bf16_t* hd = HEADS + (size_t)(b * SEQ + qb * 256) * 1024 + h * 128;
            att::attn_unit<false>(qp, kp, vp, o1, hd, lam, subln, SKV, KN, (char*)lds, ldsl, wave_k, A_->in[I_QNW], rope, qb * 256);
            att::attn_unit<true>(qp + 64, kp + 64, vp, o1, hd, lam, subln, SKV, KN, (char*)lds, ldsl, wave_k, A_->in[I_QNW], rope, qb * 256);
        }
    }
    SEAM(4);
    if (IN(5)) { PH_VARS;
        { pg8::Gemm g{HEADS, Wa_t, MTOK, DM, 1024, 1024, 1024, 0, 128, 128}; pg8::StaticOrder S; S.init(MTOK, DM, G, bx);
          pg8::Epi<pg8::E_YA> E{Mb, nullptr, nullptr, nullptr, nullptr, PG};
          pg8::gemm_phase(tid, ldsl, g, S, E); }
        __syncthreads();
        { pg8::Gemm g{POOLED, Wb_t, MTOK, DM, 1024, 1024, 1024, 0, 128, 128}; pg8::StaticOrder S; S.init(MTOK, DM, G, bx);
          pg8::Epi<pg8::E_YB> E{Mb, nullptr, nullptr, nullptr, nullptr, PG};
          pg8::gemm_phase(tid, ldsl, g, S, E); }
    }
    SEAM(5);
    if (IN(6)) { PH_VARS;
        pg8::Gemm g{Mb, Wo_t, MTOK, DM, DM, DM, DM, 0, 128, 128}; pg8::StaticOrder S; S.init(MTOK, DM, G, bx);
        pg8::Epi<pg8::E_WO> E{X1, nullptr, nullptr, A_->in[I_X], mod + 2 * DM, nullptr};
        pg8::gemm_phase(tid, ldsl, g, S, E);
    }
    SEAM(6);
    if (IN(7)) { PH_VARS; modulate_rows<bf16_t>(X1, MTOK, 16, A_->in[I_NMW], mod, 3 * DM, 4 * DM, SEQ, H2, gw, NGW, lane); }
    SEAM(7);
    if (IN(8)) { PH_VARS;
        pg8::Gemm g{H2, Wff1_t, MTOK, DFF, DM, DM, DM, 0, 128, 128}; pg8::StaticOrder S; S.init(MTOK, DFF, G, bx);
        pg8::Epi<pg8::E_FF1> E{Ub, nullptr, nullptr, nullptr, nullptr, nullptr};
        pg8::gemm_phase(tid, ldsl, g, S, E);
    }
    SEAM(8);
    if (IN(9)) { PH_VARS;
        pg8::Gemm g{Ub, Wff2_t, MTOK, DM, DFF, 64, DFF, 0, (size_t)MTOK * 128, 128};   pg8::StaticOrder S; S.init(MTOK, DM, G, bx);
        pg8::Epi<pg8::E_FF2> E{nullptr, nullptr, A_->out, nullptr, mod + 5 * DM, X1};
        pg8::gemm_phase(tid, ldsl, g, S, E);
    }
#undef IN
#undef SEAM
}

extern "C" void kernel_launch(void* const* d_in, const int* in_sizes, int n_in, void* d_out, int out_size, void* d_ws, size_t ws_size, hipStream_t stream) {
    static int grid = 0;
    if (grid == 0) {
        if (n_in != 23 || in_sizes[0] != MTOK * DM || out_size != MTOK * DM || ws_size < WS_END) {
            fprintf(stderr, "kernel_launch: shape mismatch n_in %d in0 %d out %d ws %zu (need %zu)\n", n_in, n_in > 0 ? in_sizes[0] : -1, out_size, ws_size, (size_t)WS_END); grid = -1; return; }
        int dev = 0, cus = 0, per_cu = 0;
        hipGetDevice(&dev); hipDeviceGetAttribute(&cus, hipDeviceAttributeMultiprocessorCount, dev);
        if (hipFuncSetAttribute((const void*)fwd_kernel, hipFuncAttributeMaxDynamicSharedMemorySize, LDS_BYTES) != hipSuccess) { fprintf(stderr, "kernel_launch: hipFuncSetAttribute failed\n"); grid = -1; return; }
        hipOccupancyMaxActiveBlocksPerMultiprocessor(&per_cu, (const void*)fwd_kernel, 512, LDS_BYTES);
        if (per_cu < 1) { fprintf(stderr, "kernel_launch: occupancy query says %d blocks/CU\n", per_cu); per_cu = 1; }
        (void)hipGetLastError();
        grid = cus;
    }
    if (grid < 0) return;
#if MK_MULTI
    if (hipMemsetAsync((char*)d_ws + WS_BAR, 0, 256, stream) != hipSuccess) { fprintf(stderr, "kernel_launch: memset failed\n"); return; }
#endif
    Args a{};
    for (int i = 0; i < 23; ++i) a.in[i] = (const float*)d_in[i];
    a.out = (float*)d_out; a.ws = (unsigned char*)d_ws;
#if MK_MULTI
    for (int p = 0; p < NPHASE; ++p) for (int rep = 0; rep < 1 + ((MK_REP_MASK >> p) & 1); ++rep) { a.lo = p; a.hi = p + 1; hipLaunchKernelGGL(fwd_kernel, dim3(grid), dim3(512), LDS_BYTES, stream, a); }
#else
    a.lo = 0; a.hi = NPHASE;
    void* kargs[] = {&a};
    hipError_t e = hipLaunchCooperativeKernel((const void*)fwd_kernel, dim3(grid), dim3(512), kargs, LDS_BYTES, stream);
    if (e != hipSuccess) fprintf(stderr, "cooperative launch failed: %s (grid %d)\n", hipGetErrorString(e), grid);
#endif
}
```

```cpp
#include <hip/hip_runtime.h>
#include <hip/hip_cooperative_groups.h>
#include <cstdio>
#include <cstdint>
namespace cg = cooperative_groups;

#ifndef MK_REP_MASK
#define MK_REP_MASK 0
#endif
#ifndef MK_MULTI
#define MK_MULTI 0
#endif

#define LAS __attribute__((address_space(3)))
typedef unsigned short bf16_t;
typedef short bf16x8 __attribute__((ext_vector_type(8)));
typedef short s16x4 __attribute__((ext_vector_type(4)));
typedef float f32x4 __attribute__((ext_vector_type(4)));
typedef float f32x16 __attribute__((ext_vector_type(16)));
typedef unsigned u32x4 __attribute__((ext_vector_type(4)));
typedef unsigned u32x2 __attribute__((ext_vector_type(2)));

constexpr int DM = 2048, NB = 4, SEQ = 8192, CTX = 256, MTOK = NB * SEQ, SKV = SEQ + CTX, MKV = NB * SKV;
constexpr int INW = 8192, DFF = 8192, NMOD = 6 * DM;
constexpr int LDQKV = 3072, LDPG = 5120;
constexpr float EPS = 1e-6f;
constexpr int NPHASE = 10;

constexpr size_t MiB = 1u << 20;
constexpr size_t WS_MOD = 0, WS_ROPE = 256 * 1024, WS_BAR = 512 * 1024;
constexpr size_t WS_WIN = 1 * MiB, WS_WFF1 = 33 * MiB, WS_WFF2 = 65 * MiB, WS_WO = 97 * MiB, WS_WA = 105 * MiB, WS_WB = 109 * MiB, WS_WP = 113 * MiB;
constexpr size_t WS_H = 114 * MiB, WS_HC = 242 * MiB, WS_QKV = 246 * MiB, WS_PG = 444 * MiB, WS_D = 764 * MiB, WS_POOLED = 828 * MiB, WS_OSUB = 892 * MiB;
constexpr size_t WS_HEADS = WS_OSUB + 64 * MiB, WS_X1 = WS_D  , WS_M = WS_H, WS_H2 = WS_OSUB, WS_U = WS_QKV, WS_END = 1020 * MiB;
static_assert(WS_QKV + (size_t)MKV * LDQKV * 2 <= WS_PG && WS_PG + (size_t)MTOK * LDPG * 2 <= WS_D && WS_U + (size_t)MTOK * DFF * 2 <= WS_D, "ws map");

__device__ __forceinline__ unsigned cvt_pk_bf16(float lo, float hi) { unsigned r; asm volatile("v_cvt_pk_bf16_f32 %0, %1, %2" : "=v"(r) : "v"(lo), "v"(hi)); return r; }
__device__ __forceinline__ float bflo(unsigned w) { return __uint_as_float(w << 16); }
__device__ __forceinline__ float bfhi(unsigned w) { return __uint_as_float(w & 0xffff0000u); }
__device__ __forceinline__ float wave_sum(float v) {
#pragma unroll
    for (int o = 1; o < 64; o <<= 1) v += __shfl_xor(v, o);
    return v;
}
__device__ __forceinline__ float sigmoidf_(float v) { return __builtin_amdgcn_rcpf(1.0f + __builtin_amdgcn_exp2f(-1.4426950408889634f * v)); }

__device__ __forceinline__ int lane_id_opaque() { unsigned m = ~0u; asm volatile("" : "+s"(m)); return (int)__builtin_amdgcn_mbcnt_hi(m, __builtin_amdgcn_mbcnt_lo(m, 0u)); }

namespace pg8 {
constexpr int BM = 256, BK = 64, HALF = 128, HTB = HALF * BK * 2, STAGE_BYTES = 8 * HTB, NXCD = 8, WGM = 8;
__host__ __device__ __forceinline__ int lds_byte(int r, int c) { const int st = (r >> 4) * 2 + (c >> 5), rr = r & 15, cc = c & 31, ob = rr * 64 + cc * 2; return st * 1024 + (ob ^ (((ob >> 9) & 1) << 5)); }
__host__ __device__ __forceinline__ void stage_rc(int b, int& R, int& C) { const int st = b / 1024, sb = b % 1024, swz = sb ^ (((sb >> 9) & 1) << 5); R = (st >> 1) * 16 + swz / 64; C = (st & 1) * 32 + (swz % 64) / 2; }
__host__ __device__ __forceinline__ int perm32(int rho) { const int n = rho >> 4, i = rho & 15; return 8 * (i >> 2) + 4 * n + (i & 3); }

struct Unit { int pm, pn, part; };
struct Gemm { const bf16_t* A; const bf16_t* Bt; int M, N, K, lda, ldb, akoff; size_t ksa, ksb; const bf16_t* A2; const bf16_t* Bt2; };

struct StaticOrder {
    int nM, nN, nwg, G, c;
    __device__ void init(int M, int N, int G_, int c_) { nM = M / BM; nN = N / BM; nwg = nM * nN; G = G_; c = c_; }
    __device__ bool next(int i, Unit& u) const {
        const long L = (long)i * G + c; if (L >= nwg) return false;
        int wgid = (int)L; { const int q = nwg / NXCD, r = nwg % NXCD, xcd = wgid % NXCD, off = wgid / NXCD; wgid = (xcd < r ? xcd * (q + 1) : r * (q + 1) + (xcd - r) * q) + off; }
        const int nig = WGM * nN, gid = wgid / nig, fm = gid * WGM, gsz = (nM - fm) < WGM ? (nM - fm) : WGM;
        u.pm = fm + ((wgid % nig) % gsz); u.pn = (wgid % nig) / gsz; u.part = 0; return true;
    }
};

struct PairOrder { StaticOrder S; __device__ bool next(int i, Unit& u) const { if (!S.next(i >> 1, u)) return false; u.part = i & 1; return true; } };

enum { E_G1 = 0, E_CTX, E_POOL, E_YA, E_YB, E_WO, E_FF1, E_FF2, E_YAB };
template <int MODE> struct Epi {
    bf16_t* o16; bf16_t* o16b; float* o32; const float* x32; const float* vec; const bf16_t* g16;
    static __device__ __forceinline__ u32x4 pack8(const f32x4& v0, const f32x4& v1) { u32x4 w; w.x = cvt_pk_bf16(v0[0], v0[1]); w.y = cvt_pk_bf16(v0[2], v0[3]); w.z = cvt_pk_bf16(v1[0], v1[1]); w.w = cvt_pk_bf16(v1[2], v1[3]); return w; }
    static __device__ __forceinline__ void mul8(f32x4& v0, f32x4& v1, const u32x4& g) { v0[0] *= bflo(g.x); v0[1] *= bfhi(g.x); v0[2] *= bflo(g.y); v0[3] *= bfhi(g.y); v1[0] *= bflo(g.z); v1[1] *= bfhi(g.z); v1[2] *= bflo(g.w); v1[3] *= bfhi(g.w); }
    static constexpr bool PAIRED = (MODE == E_YAB);
    __device__ __forceinline__ void mid(f32x4 (&acc)[2][2][4][2], const Unit& u, int wr, int wc, int fr, int fq) const {
        const int rowt = u.pm * BM + wr * 64 + fr, colt = u.pn * BM + wc * 32 + 8 * fq;
#pragma unroll
        for (int ai = 0; ai < 2; ++ai) {
            u32x4 ga[4][2], gb[4][2];
#pragma unroll
            for (int m = 0; m < 4; ++m)
#pragma unroll
                for (int bj = 0; bj < 2; ++bj) { const bf16_t* gp = g16 + (size_t)(rowt + ai * HALF + m * 16) * LDPG + 1024 + colt + bj * HALF;
                    ga[m][bj] = *(const u32x4*)gp; gb[m][bj] = *(const u32x4*)(gp + DM); }
#pragma unroll
            for (int m = 0; m < 4; ++m)
#pragma unroll
                for (int bj = 0; bj < 2; ++bj) { const unsigned wa[4] = {ga[m][bj].x, ga[m][bj].y, ga[m][bj].z, ga[m][bj].w}, wb[4] = {gb[m][bj].x, gb[m][bj].y, gb[m][bj].z, gb[m][bj].w};
#pragma unroll
                    for (int j = 0; j < 4; ++j) { const float r0 = bflo(wa[j]) * __builtin_amdgcn_rcpf(fmaxf(bflo(wb[j]), 1.2e-38f)), r1 = bfhi(wa[j]) * __builtin_amdgcn_rcpf(fmaxf(bfhi(wb[j]), 1.2e-38f));
                        if (j < 2) { acc[ai][bj][m][0][2 * j] *= r0; acc[ai][bj][m][0][2 * j + 1] *= r1; } else { acc[ai][bj][m][1][2 * j - 4] *= r0; acc[ai][bj][m][1][2 * j - 3] *= r1; } } }
        }
    }
    static __device__ __forceinline__ void add8(f32x4& v0, f32x4& v1, const u32x4& a) { v0[0] += bflo(a.x); v0[1] += bfhi(a.x); v0[2] += bflo(a.y); v0[3] += bfhi(a.y); v1[0] += bflo(a.z); v1[1] += bfhi(a.z); v1[2] += bflo(a.w); v1[3] += bfhi(a.w); }
    __device__ __forceinline__ void operator()(const f32x4 (&acc)[2][2][4][2], const Unit& u, int wr, int wc, int fr, int fq) const {
        const int rowt = u.pm * BM + wr * 64 + fr, colt = u.pn * BM + wc * 32 + 8 * fq;
        if constexpr (MODE == E_WO || MODE == E_FF2) {
            const float* gv = vec + (size_t)(rowt >> 13) * NMOD + colt;
            f32x4 g[2][2];
#pragma unroll
            for (int bj = 0; bj < 2; ++bj) { g[bj][0] = *(const f32x4*)(gv + bj * HALF); g[bj][1] = *(const f32x4*)(gv + bj * HALF + 4); }
#pragma unroll
            for (int ai = 0; ai < 2; ++ai) {
                if constexpr (MODE == E_WO) {
                    f32x4 xb[4][2][2];
#pragma unroll
                    for (int m = 0; m < 4; ++m)
#pragma unroll
                        for (int bj = 0; bj < 2; ++bj) { const size_t off = (size_t)(rowt + ai * HALF + m * 16) * DM + colt + bj * HALF;
                            xb[m][bj][0] = __builtin_nontemporal_load((const f32x4*)(x32 + off)); xb[m][bj][1] = __builtin_nontemporal_load((const f32x4*)(x32 + off + 4)); }
#pragma unroll
                    for (int m = 0; m < 4; ++m)
#pragma unroll
                        for (int bj = 0; bj < 2; ++bj) { const size_t off = (size_t)(rowt + ai * HALF + m * 16) * DM + colt + bj * HALF;
                            *(u32x4*)(o16 + off) = pack8(xb[m][bj][0] + g[bj][0] * acc[ai][bj][m][0], xb[m][bj][1] + g[bj][1] * acc[ai][bj][m][1]); }
                } else {
                    u32x4 xb[4][2];
#pragma unroll
                    for (int m = 0; m < 4; ++m)
#pragma unroll
                        for (int bj = 0; bj < 2; ++bj) xb[m][bj] = *(const u32x4*)(g16 + (size_t)(rowt + ai * HALF + m * 16) * DM + colt + bj * HALF);
#pragma unroll
                    for (int m = 0; m < 4; ++m)
#pragma unroll
                        for (int bj = 0; bj < 2; ++bj) { const size_t off = (size_t)(rowt + ai * HALF + m * 16) * DM + colt + bj * HALF;
                            f32x4 v0 = g[bj][0] * acc[ai][bj][m][0], v1 = g[bj][1] * acc[ai][bj][m][1];
                            add8(v0, v1, xb[m][bj]);
                            *(f32x4*)(o32 + off) = v0; *(f32x4*)(o32 + off + 4) = v1; }
                }
            }
        } else if constexpr (MODE == E_YA || MODE == E_YB || MODE == E_YAB) {
#pragma unroll
            for (int ai = 0; ai < 2; ++ai) {
                u32x4 gb[4][2], mb[4][2];
#pragma unroll
                for (int m = 0; m < 4; ++m)
#pragma unroll
                    for (int bj = 0; bj < 2; ++bj) { const int row = rowt + ai * HALF + m * 16, col = colt + bj * HALF;
                        gb[m][bj] = *(const u32x4*)(g16 + (size_t)row * LDPG + 1024 + (MODE == E_YA ? 0 : DM) + col);
                        if constexpr (MODE == E_YB) mb[m][bj] = *(const u32x4*)(o16 + (size_t)row * DM + col); }
#pragma unroll
                for (int m = 0; m < 4; ++m)
#pragma unroll
                    for (int bj = 0; bj < 2; ++bj) { const int row = rowt + ai * HALF + m * 16, col = colt + bj * HALF;
                        f32x4 v0 = acc[ai][bj][m][0], v1 = acc[ai][bj][m][1];
                        mul8(v0, v1, gb[m][bj]);
                        if constexpr (MODE == E_YB) add8(v0, v1, mb[m][bj]);
                        *(u32x4*)(o16 + (size_t)row * DM + col) = pack8(v0, v1); }
            }
        } else {
#pragma unroll
        for (int ai = 0; ai < 2; ++ai)
#pragma unroll
            for (int m = 0; m < 4; ++m) {
                const int row = rowt + ai * HALF + m * 16;
#pragma unroll
                for (int bj = 0; bj < 2; ++bj) {
                    const int col = colt + bj * HALF;
                    f32x4 v0 = acc[ai][bj][m][0], v1 = acc[ai][bj][m][1];
                    if constexpr (MODE == E_G1) {
                        bf16_t* p;
                        if (u.pn < 12) { p = o16 + (size_t)(row + (row >> 13) * CTX) * LDQKV + col; }
                        else { p = o16b + (size_t)row * LDPG + (col - 3072);
                            if (u.pn >= 16) {
#pragma unroll
                                for (int j = 0; j < 4; ++j) { v0[j] = sigmoidf_(v0[j]); v1[j] = sigmoidf_(v1[j]); } } }
                        *(u32x4*)p = pack8(v0, v1);
                    } else if constexpr (MODE == E_CTX) {
                        *(u32x4*)(o16 + (size_t)(u.pm * SKV + SEQ + (row - u.pm * BM)) * LDQKV + 1024 + col) = pack8(v0, v1);
                    } else if constexpr (MODE == E_POOL) {
                        const f32x4 s0 = *(const f32x4*)(vec + col), s1 = *(const f32x4*)(vec + col + 4);
                        v0 = v0 * s0; v1 = v1 * s1;
                        *(u32x4*)(o16 + (size_t)row * 1024 + col) = pack8(v0, v1);
                    } else if constexpr (MODE == E_FF1) {
#pragma unroll
                        for (int j = 0; j < 4; ++j) { const float a = fmaxf(v0[j], 0.f), b = fmaxf(v1[j], 0.f); v0[j] = a * a; v1[j] = b * b; }
                        __builtin_nontemporal_store(pack8(v0, v1), (u32x4*)(o16 + (size_t)(col >> 6) * ((size_t)MTOK * 64) + (size_t)row * 64 + (col & 63)));
                    }
                }
            }
        }
    }
};

template <class EpiT, class SchedT>
__device__ __forceinline__ void gemm_phase(const int tid, LAS unsigned char* lds, const Gemm g, const SchedT& S, const EpiT& E) {
    const int wid = __builtin_amdgcn_readfirstlane(tid >> 6), lane = tid & 63, wr = wid >> 2, wc = wid & 3, fr = lane & 15, fq = lane >> 4;
    const int K = g.K, nt = K / BK;
    unsigned voffA[2], voffB[2];
#pragma unroll
    for (int i = 0; i < 2; ++i) { int R, C; stage_rc(tid * 16 + i * 8192, R, C); const int Rb = (R & ~31) + perm32(R & 31);
        voffA[i] = (unsigned)(R * g.lda + C) * 2u; voffB[i] = (unsigned)(Rb * g.ldb + C) * 2u; }
    const size_t kstepA = g.ksa, kstepB = g.ksb;
    const size_t hstepA = (size_t)HALF * g.lda * 2, hstepB = (size_t)HALF * g.ldb * 2;
    const size_t tstepA = 2 * hstepA, tstepB = 2 * hstepB;
    const unsigned ldsw = (unsigned)wid * 1024u;
    const int aoff = lds_byte(wr * 64 + fr, fq * 8), boff = lds_byte(wc * 32 + fr, fq * 8);
#define PG8_SA(b, h) (((b) * 2 + (h)) * HTB)
#define PG8_SB(b, h) ((4 + (b) * 2 + (h)) * HTB)
#define PG8_STAGE(bufoff, gbase, voff) do { _Pragma("unroll") for (int _i = 0; _i < 2; ++_i) \
        __builtin_amdgcn_global_load_lds((const unsigned*)((const char*)(gbase) + (voff)[_i]), (LAS unsigned*)(lds + (bufoff) + ldsw + _i * 8192), 16, 0, 0); } while (0)
#define PG8_LDA(dst, b, h) do { _Pragma("unroll") for (int m = 0; m < 4; ++m) _Pragma("unroll") for (int k = 0; k < 2; ++k) dst[m][k] = *(const LAS bf16x8*)(lds + PG8_SA(b, h) + aoff + m * 2048 + k * 1024); } while (0)
#define PG8_LDB(dst, b, h) do { _Pragma("unroll") for (int n = 0; n < 2; ++n) _Pragma("unroll") for (int k = 0; k < 2; ++k) dst[n][k] = *(const LAS bf16x8*)(lds + PG8_SB(b, h) + boff + n * 2048 + k * 1024); } while (0)
#define PG8_MMA(ai, bj, At, Bt) do { __builtin_amdgcn_s_setprio(1); _Pragma("unroll") for (int m = 0; m < 4; ++m) _Pragma("unroll") for (int n = 0; n < 2; ++n) _Pragma("unroll") for (int k = 0; k < 2; ++k) \
        acc[ai][bj][m][n] = __builtin_amdgcn_mfma_f32_16x16x32_bf16(Bt[n][k], At[m][k], acc[ai][bj][m][n], 0, 0, 0); __builtin_amdgcn_s_setprio(0); } while (0)
#define PG8_WAIT_V(n) asm volatile("s_waitcnt vmcnt(" #n ")" ::: "memory")
#define PG8_WAIT_L(n) asm volatile("s_waitcnt lgkmcnt(" #n ")" ::: "memory")
#define PG8_BAR __builtin_amdgcn_s_barrier()
#define PG8_SCHED __builtin_amdgcn_sched_barrier(0)
    Unit cur, nxt; int ui = 0;
    if (!S.next(0, cur)) return;
    f32x4 acc[2][2][4][2];
#pragma unroll
    for (int a = 0; a < 2; ++a)
#pragma unroll
        for (int b = 0; b < 2; ++b)
#pragma unroll
            for (int m = 0; m < 4; ++m)
#pragma unroll
                for (int n = 0; n < 2; ++n) acc[a][b][m][n] = (f32x4){0.f, 0.f, 0.f, 0.f};
    bf16x8 At[4][2], B0[2][2], B1[2][2];
    const char* cA = (const char*)(cur.part ? g.A2 : g.A) + (size_t)cur.pm * tstepA + (size_t)cur.pn * g.akoff * 2; const char* cB = (const char*)(cur.part ? g.Bt2 : g.Bt) + (size_t)cur.pn * tstepB;
    PG8_STAGE(PG8_SB(0, 0), cB, voffB); PG8_STAGE(PG8_SB(0, 1), cB + hstepB, voffB); PG8_STAGE(PG8_SA(0, 0), cA, voffA); PG8_STAGE(PG8_SA(0, 1), cA + hstepA, voffA);
    if (wr == 1) PG8_BAR;
    PG8_WAIT_V(2); PG8_BAR;
    PG8_STAGE(PG8_SB(1, 0), cB + kstepB, voffB); PG8_STAGE(PG8_SA(1, 0), cA + kstepA, voffA); PG8_STAGE(PG8_SB(1, 1), cB + hstepB + kstepB, voffB);
    PG8_WAIT_V(6); PG8_BAR;
    for (;;) {
        const bool has_next = S.next(ui + 1, nxt);
        const char* nA = has_next ? (const char*)(nxt.part ? g.A2 : g.A) + (size_t)nxt.pm * tstepA + (size_t)nxt.pn * g.akoff * 2 : cA; const char* nB = has_next ? (const char*)(nxt.part ? g.Bt2 : g.Bt) + (size_t)nxt.pn * tstepB : cB;
        for (int t = 0; t < nt; t += 2) {
            const bool last = (t == nt - 2);
            const char* a1 = cA + (size_t)(t + 1) * kstepA;
            const char* a2 = last ? nA : cA + (size_t)(t + 2) * kstepA; const char* b2 = last ? nB : cB + (size_t)(t + 2) * kstepB;
            const char* a3 = a2 + kstepA; const char* b3 = b2 + kstepB;
            PG8_LDB(B0, 0, 0); PG8_LDB(B1, 0, 1); PG8_SCHED; PG8_LDA(At, 0, 0); PG8_STAGE(PG8_SA(1, 1), a1 + hstepA, voffA);
            PG8_WAIT_V(8); PG8_WAIT_L(0); PG8_BAR; PG8_MMA(0, 0, At, B0); PG8_MMA(0, 1, At, B1); PG8_BAR; PG8_SCHED;
            PG8_LDA(At, 0, 1); PG8_STAGE(PG8_SB(0, 0), b2, voffB); PG8_STAGE(PG8_SB(0, 1), b2 + hstepB, voffB); PG8_STAGE(PG8_SA(0, 0), a2, voffA);
            PG8_WAIT_V(8); PG8_WAIT_L(0); PG8_BAR; PG8_MMA(1, 0, At, B0); PG8_MMA(1, 1, At, B1); PG8_BAR; PG8_SCHED;
            PG8_LDB(B0, 1, 0); PG8_LDB(B1, 1, 1); PG8_SCHED; PG8_LDA(At, 1, 0); PG8_STAGE(PG8_SA(0, 1), a2 + hstepA, voffA);
            PG8_WAIT_V(8); PG8_WAIT_L(0); PG8_BAR; PG8_MMA(0, 0, At, B0); PG8_MMA(0, 1, At, B1); PG8_BAR; PG8_SCHED;
            PG8_LDA(At, 1, 1); PG8_STAGE(PG8_SB(1, 0), b3, voffB); PG8_STAGE(PG8_SB(1, 1), b3 + hstepB, voffB); PG8_STAGE(PG8_SA(1, 0), a3, voffA);
            PG8_WAIT_V(8); PG8_WAIT_L(0); PG8_BAR; PG8_MMA(1, 0, At, B0); PG8_MMA(1, 1, At, B1); PG8_BAR; PG8_SCHED;
        }
        if (wr == 0) PG8_BAR;
        bool keep = false;
        if constexpr (EpiT::PAIRED) { if (cur.part == 0) { E.mid(acc, cur, wr, wc, fr, fq); keep = true; } else E(acc, cur, wr, wc, fr, fq); } else E(acc, cur, wr, wc, fr, fq);
        if (!has_next) break;
        if (!keep)
#pragma unroll
        for (int a = 0; a < 2; ++a)
#pragma unroll
            for (int b = 0; b < 2; ++b)
#pragma unroll
                for (int m = 0; m < 4; ++m)
#pragma unroll
                    for (int n = 0; n < 2; ++n) acc[a][b][m][n] = (f32x4){0.f, 0.f, 0.f, 0.f};
        cur = nxt; cA = nA; cB = nB; ++ui;
        if (wr == 1) PG8_BAR;
    }
    PG8_WAIT_V(0);
    PG8_BAR;
#undef PG8_SA
#undef PG8_SB
#undef PG8_STAGE
#undef PG8_LDA
#undef PG8_LDB
#undef PG8_MMA
#undef PG8_WAIT_V
#undef PG8_WAIT_L
#undef PG8_BAR
#undef PG8_SCHED
}
}

namespace att {
constexpr int NW = 8, QBLK = 32, KVBLK = 64;
constexpr float QSCALE = 0.125f * 1.4426950408889634f;
constexpr int SHM_V = KVBLK * 128 * 2, SHM_K = KVBLK * 64 * 2, NBUF = 4;
#define KSWZ64(row, colB) ((row) * 128 + ((colB) ^ ((((row) >> 1) & 7) << 4)))
#define SBAR() __builtin_amdgcn_sched_barrier(0)
__device__ __forceinline__ int crow(int r, int hi) { return (r & 3) + 8 * (r >> 2) + 4 * hi; }
#define PK4(P, BASE, OUT) do { unsigned a0 = cvt_pk_bf16(P[BASE + 0], P[BASE + 1]), a1 = cvt_pk_bf16(P[BASE + 2], P[BASE + 3]);   \
    unsigned b0 = cvt_pk_bf16(P[BASE + 4], P[BASE + 5]), b1 = cvt_pk_bf16(P[BASE + 6], P[BASE + 7]);                              \
    auto r0 = __builtin_amdgcn_permlane32_swap(a0, b0, false, false); auto r1 = __builtin_amdgcn_permlane32_swap(a1, b1, false, false); \
    u32x4 w = {r0[0], r1[0], r0[1], r1[1]}; OUT = *reinterpret_cast<bf16x8*>(&w); } while (0)
__device__ __forceinline__ void partialSM(f32x16& p0, float& l_reg, bf16x8& pa0, bf16x8& pa1) {
#pragma unroll
    for (int r = 0; r < 16; ++r) p0[r] = __builtin_amdgcn_exp2f(p0[r]);
    float ps = 0;
#pragma unroll
    for (int r = 0; r < 16; ++r) ps += p0[r];
    l_reg += ps;
    PK4(p0, 0, pa0); PK4(p0, 8, pa1);
}
__device__ __forceinline__ void finishSM(f32x16& p1, float& l_reg, bf16x8& pa2, bf16x8& pa3) {
#pragma unroll
    for (int r = 0; r < 16; ++r) p1[r] = __builtin_amdgcn_exp2f(p1[r]);
    float ps = 0;
#pragma unroll
    for (int r = 0; r < 16; ++r) ps += p1[r];
    l_reg += ps;
    PK4(p1, 0, pa2); PK4(p1, 8, pa3);
}
#undef PK4
__device__ __forceinline__ void qkt(f32x16& p0, f32x16& p1, const char* Ks, const bf16x8* qr, const f32x16& negm, int r32, int hi) {
#pragma unroll
    for (int d0 = 0; d0 < 4; ++d0) { const int cb = d0 * 32 + hi * 16;
        bf16x8 b0 = *reinterpret_cast<const bf16x8*>(Ks + KSWZ64(r32, cb));
        bf16x8 b1 = *reinterpret_cast<const bf16x8*>(Ks + KSWZ64(32 + r32, cb));
        if (d0 == 0) { p0 = __builtin_amdgcn_mfma_f32_32x32x16_bf16(b0, qr[0], negm, 0, 0, 0); p1 = __builtin_amdgcn_mfma_f32_32x32x16_bf16(b1, qr[0], negm, 0, 0, 0); }
        else { p0 = __builtin_amdgcn_mfma_f32_32x32x16_bf16(b0, qr[d0], p0, 0, 0, 0); p1 = __builtin_amdgcn_mfma_f32_32x32x16_bf16(b1, qr[d0], p1, 0, 0, 0); } }
}
__device__ __forceinline__ int v_st(int k, int c) { const int kk = (k & ~0xC) | ((k & 4) << 1) | ((k & 8) >> 1); return ((kk >> 3) * 4 + (c >> 5)) * 512 + ((kk & 7) * 32 + (c & 31)) * 2; }
__device__ __forceinline__ int v_rd_base(int lane) { return ((lane & 3) << 3) | (((lane >> 2) & 3) << 6) | (((lane >> 4) & 1) << 5) | (((lane >> 5) & 1) << 8); }
constexpr int v_rd_off(int d0, int ks, int half) { return d0 * 512 + ks * 4096 + half * 2048; }
template <int OFF> __device__ __forceinline__ s16x4 tr_read(int vb) {
    s16x4 r; asm volatile("ds_read_b64_tr_b16 %0, %1 offset:%2" : "=&v"(r) : "v"(vb), "i"(OFF) : "memory"); return r;
}
template <int D0> __device__ __forceinline__ void pv_one(f32x16& od, int vb, bf16x8 pa0, bf16x8 pa1, bf16x8 pa2, bf16x8 pa3) {
    const s16x4 l0 = tr_read<v_rd_off(D0, 0, 0)>(vb), h0 = tr_read<v_rd_off(D0, 0, 1)>(vb), l1 = tr_read<v_rd_off(D0, 1, 0)>(vb), h1 = tr_read<v_rd_off(D0, 1, 1)>(vb);
    const s16x4 l2 = tr_read<v_rd_off(D0, 2, 0)>(vb), h2 = tr_read<v_rd_off(D0, 2, 1)>(vb), l3 = tr_read<v_rd_off(D0, 3, 0)>(vb), h3 = tr_read<v_rd_off(D0, 3, 1)>(vb);
    asm volatile("s_waitcnt lgkmcnt(0)" ::: "memory"); SBAR();
#define PK(L, H) (bf16x8){L[0], L[1], L[2], L[3], H[0], H[1], H[2], H[3]}
    od = __builtin_amdgcn_mfma_f32_32x32x16_bf16(pa0, PK(l0, h0), od, 0, 0, 0);
    od = __builtin_amdgcn_mfma_f32_32x32x16_bf16(pa1, PK(l1, h1), od, 0, 0, 0);
    od = __builtin_amdgcn_mfma_f32_32x32x16_bf16(pa2, PK(l2, h2), od, 0, 0, 0);
    od = __builtin_amdgcn_mfma_f32_32x32x16_bf16(pa3, PK(l3, h3), od, 0, 0, 0);
#undef PK
}
__device__ __forceinline__ void pv_d0(f32x16* o, int vb, bf16x8 pa0, bf16x8 pa1, bf16x8 pa2, bf16x8 pa3) {
    pv_one<0>(o[0], vb, pa0, pa1, pa2, pa3); pv_one<1>(o[1], vb, pa0, pa1, pa2, pa3); pv_one<2>(o[2], vb, pa0, pa1, pa2, pa3); pv_one<3>(o[3], vb, pa0, pa1, pa2, pa3);
}
#define PKF(L, H) (bf16x8){L[0], L[1], L[2], L[3], H[0], H[1], H[2], H[3]}
template <int I, bool EXPS> __device__ __forceinline__ void pv_roll_step(f32x16* o, int vb, const bf16x8& pa0, const bf16x8& pa1, const bf16x8& pa2, const bf16x8& pa3, s16x4 (&L)[4], s16x4 (&H)[4], f32x16& c0, float& ps, unsigned (&cv)[4], bf16x8& ca0) {
    constexpr int ks = I >> 2, d0 = I & 3, sl = I & 3, rem = 15 - I, n = 2 * (rem < 3 ? rem : 3);
    asm volatile("s_waitcnt lgkmcnt(%0)" :: "n"(n) : "memory"); SBAR();
    o[d0] = __builtin_amdgcn_mfma_f32_32x32x16_bf16(ks == 0 ? pa0 : ks == 1 ? pa1 : ks == 2 ? pa2 : pa3, PKF(L[sl], H[sl]), o[d0], 0, 0, 0);
    if constexpr (EXPS) { c0[I] = __builtin_amdgcn_exp2f(c0[I]); if constexpr (I >= 1) ps += c0[I - 1];
        if constexpr (I == 9) { cv[0] = cvt_pk_bf16(c0[0], c0[1]); cv[1] = cvt_pk_bf16(c0[2], c0[3]); cv[2] = cvt_pk_bf16(c0[4], c0[5]); cv[3] = cvt_pk_bf16(c0[6], c0[7]); }
        if constexpr (I == 10) { auto r0 = __builtin_amdgcn_permlane32_swap(cv[0], cv[2], false, false); auto r1 = __builtin_amdgcn_permlane32_swap(cv[1], cv[3], false, false);
            u32x4 w = {r0[0], r1[0], r0[1], r1[1]}; ca0 = *reinterpret_cast<bf16x8*>(&w); } }
    if constexpr (I + 4 < 16) { SBAR(); L[sl] = tr_read<v_rd_off((I + 4) & 3, (I + 4) >> 2, 0)>(vb); H[sl] = tr_read<v_rd_off((I + 4) & 3, (I + 4) >> 2, 1)>(vb); }
}
__device__ __forceinline__ void pv_window0(int vb, s16x4 (&L)[4], s16x4 (&H)[4]) {
    L[0] = tr_read<v_rd_off(0, 0, 0)>(vb); H[0] = tr_read<v_rd_off(0, 0, 1)>(vb); L[1] = tr_read<v_rd_off(1, 0, 0)>(vb); H[1] = tr_read<v_rd_off(1, 0, 1)>(vb);
    L[2] = tr_read<v_rd_off(2, 0, 0)>(vb); H[2] = tr_read<v_rd_off(2, 0, 1)>(vb); L[3] = tr_read<v_rd_off(3, 0, 0)>(vb); H[3] = tr_read<v_rd_off(3, 0, 1)>(vb);
}
template <bool EXPS> __device__ __forceinline__ void pv_roll(f32x16* o, int vb, const bf16x8& pa0, const bf16x8& pa1, const bf16x8& pa2, const bf16x8& pa3, s16x4 (&L)[4], s16x4 (&H)[4], f32x16& c0, float& l_reg, bf16x8& ca0, bf16x8& ca1) {
    float ps = 0.f; unsigned cv[4] = {0u, 0u, 0u, 0u};
    pv_roll_step<0, EXPS>(o, vb, pa0, pa1, pa2, pa3, L, H, c0, ps, cv, ca0);   pv_roll_step<1, EXPS>(o, vb, pa0, pa1, pa2, pa3, L, H, c0, ps, cv, ca0);   pv_roll_step<2, EXPS>(o, vb, pa0, pa1, pa2, pa3, L, H, c0, ps, cv, ca0);   pv_roll_step<3, EXPS>(o, vb, pa0, pa1, pa2, pa3, L, H, c0, ps, cv, ca0);
    pv_roll_step<4, EXPS>(o, vb, pa0, pa1, pa2, pa3, L, H, c0, ps, cv, ca0);   pv_roll_step<5, EXPS>(o, vb, pa0, pa1, pa2, pa3, L, H, c0, ps, cv, ca0);   pv_roll_step<6, EXPS>(o, vb, pa0, pa1, pa2, pa3, L, H, c0, ps, cv, ca0);   pv_roll_step<7, EXPS>(o, vb, pa0, pa1, pa2, pa3, L, H, c0, ps, cv, ca0);
    pv_roll_step<8, EXPS>(o, vb, pa0, pa1, pa2, pa3, L, H, c0, ps, cv, ca0);   pv_roll_step<9, EXPS>(o, vb, pa0, pa1, pa2, pa3, L, H, c0, ps, cv, ca0);   pv_roll_step<10, EXPS>(o, vb, pa0, pa1, pa2, pa3, L, H, c0, ps, cv, ca0);  pv_roll_step<11, EXPS>(o, vb, pa0, pa1, pa2, pa3, L, H, c0, ps, cv, ca0);
    pv_roll_step<12, EXPS>(o, vb, pa0, pa1, pa2, pa3, L, H, c0, ps, cv, ca0);  pv_roll_step<13, EXPS>(o, vb, pa0, pa1, pa2, pa3, L, H, c0, ps, cv, ca0);  pv_roll_step<14, EXPS>(o, vb, pa0, pa1, pa2, pa3, L, H, c0, ps, cv, ca0);  pv_roll_step<15, EXPS>(o, vb, pa0, pa1, pa2, pa3, L, H, c0, ps, cv, ca0);
    SBAR();
    if constexpr (EXPS) { ps += c0[15]; l_reg += ps;
        unsigned a0 = cvt_pk_bf16(c0[8], c0[9]), a1 = cvt_pk_bf16(c0[10], c0[11]), b0 = cvt_pk_bf16(c0[12], c0[13]), b1 = cvt_pk_bf16(c0[14], c0[15]);
        auto r0 = __builtin_amdgcn_permlane32_swap(a0, b0, false, false); auto r1 = __builtin_amdgcn_permlane32_swap(a1, b1, false, false);
        u32x4 w = {r0[0], r1[0], r0[1], r1[1]}; ca1 = *reinterpret_cast<bf16x8*>(&w); }
}
__device__ __forceinline__ void partialSM_tail(f32x16& p0, float& l_reg, bf16x8& pa0, bf16x8& pa1) {
    float ps = 0;
#pragma unroll
    for (int r = 0; r < 16; ++r) ps += p0[r];
    l_reg += ps;
#define PK4(P, BASE, OUT) do { unsigned a0 = cvt_pk_bf16(P[BASE + 0], P[BASE + 1]), a1 = cvt_pk_bf16(P[BASE + 2], P[BASE + 3]);   \
    unsigned b0 = cvt_pk_bf16(P[BASE + 4], P[BASE + 5]), b1 = cvt_pk_bf16(P[BASE + 6], P[BASE + 7]);                              \
    auto r0 = __builtin_amdgcn_permlane32_swap(a0, b0, false, false); auto r1 = __builtin_amdgcn_permlane32_swap(a1, b1, false, false); \
    u32x4 w = {r0[0], r1[0], r0[1], r1[1]}; OUT = *reinterpret_cast<bf16x8*>(&w); } while (0)
    PK4(p0, 0, pa0); PK4(p0, 8, pa1);
#undef PK4
}
#undef PKF
template <bool SECOND>
__device__ __forceinline__ void attn_unit(const bf16_t* __restrict__ Qb, const bf16_t* __restrict__ Kh, const bf16_t* __restrict__ Vh, bf16_t* O1, bf16_t* Hd, float lam, const float* subln, int seq, float KN, char* lds, LAS unsigned char* ldsl, const int wave_s, const float* qnw, const float* rope, const int t0) {
    int tid = wave_s * 64 + lane_id_opaque(); asm volatile("" : "+v"(tid));
    const int wid = __builtin_amdgcn_readfirstlane(tid >> 6), lane = tid & 63, r32 = lane & 31, hi = lane >> 5;
    constexpr int KOFF = NBUF * SHM_V;
    char* V_lds = lds; char* K_lds = lds + KOFF;
    float* ws = (float*)(lds + NBUF * SHM_V + NBUF * SHM_K) + wid * 64; float* li_l = ws;
    float l_reg = 0; f32x16 o[4] = {}; bf16x8 qr[4];
    const bf16_t* Qw = Qb + (long)(wid * QBLK + r32) * LDQKV + hi * 8;
#pragma unroll
    for (int d0 = 0; d0 < 4; ++d0) qr[d0] = *reinterpret_cast<const bf16x8*>(Qw + d0 * 16);
    { float y[4][8]; float ss = 0.f;
#pragma unroll
      for (int d0 = 0; d0 < 4; ++d0)
#pragma unroll
          for (int e = 0; e < 8; ++e) { y[d0][e] = __uint_as_float(((unsigned)(unsigned short)qr[d0][e]) << 16); ss += y[d0][e] * y[d0][e]; }
      { auto rr = __builtin_amdgcn_permlane32_swap(__float_as_uint(ss), __float_as_uint(ss), false, false); ss = __uint_as_float(rr[0]) + __uint_as_float(rr[1]); }
      const float rstd = rsqrtf(ss * (1.f / 64.f) + EPS);
#pragma unroll
      for (int d0 = 0; d0 < 4; ++d0) { const f32x4 w0 = *(const f32x4*)(qnw + d0 * 16 + hi * 8), w1 = *(const f32x4*)(qnw + d0 * 16 + hi * 8 + 4);
#pragma unroll
          for (int e = 0; e < 4; ++e) { y[d0][e] *= rstd * w0[e]; y[d0][e + 4] *= rstd * w1[e]; } }
      const int t = t0 + wid * QBLK + r32;
      const float* tr = rope + (t >> 6) * 32 + hi * 16; const float* tc = rope + (t & 63) * 32 + hi * 16;
#pragma unroll
      for (int e = 0; e < 8; ++e) { const float cr = tr[2 * e], sr = tr[2 * e + 1], cc = tc[2 * e], sc = tc[2 * e + 1];
          const float a = y[0][e], b = y[1][e], c = y[2][e], d = y[3][e];
          y[0][e] = a * cr - b * sr; y[1][e] = a * sr + b * cr; y[2][e] = c * cc - d * sc; y[3][e] = c * sc + d * cc; }
#pragma unroll
      for (int d0 = 0; d0 < 4; ++d0) { u32x4 w; w.x = cvt_pk_bf16(y[d0][0] * QSCALE, y[d0][1] * QSCALE); w.y = cvt_pk_bf16(y[d0][2] * QSCALE, y[d0][3] * QSCALE);
          w.z = cvt_pk_bf16(y[d0][4] * QSCALE, y[d0][5] * QSCALE); w.w = cvt_pk_bf16(y[d0][6] * QSCALE, y[d0][7] * QSCALE); qr[d0] = *reinterpret_cast<bf16x8*>(&w); } }
    unsigned kgo, vgo0, vgo1;
    { const int row = wid * 8 + (lane >> 3), colB = ((lane & 7) * 16) ^ (((row >> 1) & 7) << 4);
      kgo = (unsigned)(row * LDQKV * 2 + colB);
      const int st0 = wid * 2 + (lane >> 5), st1 = 16 + st0, klo = (lane & 31) >> 2, cl = (lane & 3) * 8;
      const int kk0 = (st0 >> 2) * 8 + klo, kk1 = (st1 >> 2) * 8 + klo;
      const int k0 = (kk0 & ~0xC) | ((kk0 & 4) << 1) | ((kk0 & 8) >> 1), k1 = (kk1 & ~0xC) | ((kk1 & 4) << 1) | ((kk1 & 8) >> 1);
      const unsigned dv = (unsigned)((const char*)Vh - (const char*)Kh);
      vgo0 = dv + (unsigned)((k0 * LDQKV + (st0 & 3) * 32 + cl) * 2); vgo1 = dv + (unsigned)((k1 * LDQKV + (st1 & 3) * 32 + cl) * 2); }
#define DMA(t, slot) do { const char* gb_ = (const char*)Kh + (size_t)(t) * (KVBLK * LDQKV * 2); \
    __builtin_amdgcn_global_load_lds((const unsigned*)(gb_ + kgo), (LAS unsigned*)(ldsl + KOFF + (slot) * SHM_K + wid * 1024), 16, 0, 0); \
    __builtin_amdgcn_global_load_lds((const unsigned*)(gb_ + vgo0), (LAS unsigned*)(ldsl + (slot) * SHM_V + wid * 1024), 16, 0, 0); \
    __builtin_amdgcn_global_load_lds((const unsigned*)(gb_ + vgo1), (LAS unsigned*)(ldsl + (slot) * SHM_V + 8192 + wid * 1024), 16, 0, 0); } while (0)
#define WAIT_BAR(N) asm volatile("s_waitcnt vmcnt(" #N ") lgkmcnt(0)\n\ts_barrier" ::: "memory")
    DMA(0, 0); DMA(1, 1);
    f32x16 negm;
    { float ss = 0.f;
#pragma unroll
      for (int d0 = 0; d0 < 4; ++d0)
#pragma unroll
          for (int e = 0; e < 8; ++e) { const float v = __uint_as_float(((unsigned)(unsigned short)qr[d0][e]) << 16); ss += v * v; }
      auto rr = __builtin_amdgcn_permlane32_swap(__float_as_uint(ss), __float_as_uint(ss), false, false);
      ss = __uint_as_float(rr[0]) + __uint_as_float(rr[1]);
      const float nb = -sqrtf(ss) * KN;
#pragma unroll
      for (int r = 0; r < 16; ++r) negm[r] = nb; }
    const int vb0 = (int)(uintptr_t)V_lds + v_rd_base(lane);
    f32x16 pA0, pA1, pB0, pB1; bf16x8 paA0, paA1, paB0, paB1, pa2, pa3; const int NT = seq / KVBLK;
    const bool grpB = false;
    WAIT_BAR(3);
    DMA(2, 2);
    qkt(pA0, pA1, K_lds, qr, negm, r32, hi); partialSM(pA0, l_reg, paA0, paA1);
    WAIT_BAR(3);
    if (grpB) WAIT_BAR(3);
#define STEP(j, C0, C1, CA0, CA1, P1, PA0, PA1) do { \
        if ((j) + 2 < NT) DMA((j) + 2, ((j) + 2) & 3); \
        const int vb_ = vb0 + (((j) - 1) & 3) * SHM_V; \
        SBAR(); pv_window0(vb_, VL, VH); SBAR(); \
        qkt(C0, C1, K_lds + ((j) & 3) * SHM_K, qr, negm, r32, hi); \
        finishSM(P1, l_reg, pa2, pa3); SBAR(); \
        pv_roll<true>(o, vb_, PA0, PA1, pa2, pa3, VL, VH, C0, l_reg, CA0, CA1); SBAR(); \
        if ((j) + 2 < NT) WAIT_BAR(3); else WAIT_BAR(0); } while (0)
    s16x4 VL[4], VH[4];
    for (int j = 1; j + 1 < NT; j += 2) {
        STEP(j, pB0, pB1, paB0, paB1, pA1, paA0, paA1);
        STEP(j + 1, pA0, pA1, paA0, paA1, pB1, paB0, paB1);
    }
    STEP(NT - 1, pB0, pB1, paB0, paB1, pA1, paA0, paA1);
    finishSM(pB1, l_reg, pa2, pa3); SBAR();
    pv_window0(vb0 + ((NT - 1) & 3) * SHM_V, VL, VH);
    pv_roll<false>(o, vb0 + ((NT - 1) & 3) * SHM_V, paB0, paB1, pa2, pa3, VL, VH, pB0, l_reg, paB0, paB1);
    if (!grpB) WAIT_BAR(0);
#undef STEP
    { auto rr = __builtin_amdgcn_permlane32_swap(__float_as_uint(l_reg), __float_as_uint(l_reg), false, false); l_reg = __uint_as_float(rr[0]) + __uint_as_float(rr[1]); }
    if (hi == 0) li_l[r32] = l_reg; asm volatile("s_waitcnt lgkmcnt(0)" ::: "memory");
    float rli[16];
#pragma unroll
    for (int r = 0; r < 16; ++r) rli[r] = __builtin_amdgcn_rcpf(li_l[crow(r, hi)]);
#define ROWWALK(PTR, r) do { PTR += ((r) & 3) == 3 ? 5 * 1024 : 1024; asm volatile("" : "+v"(PTR)); } while (0)
    const long lane_off = (long)(wid * QBLK + 4 * hi) * 1024 + r32;
    if constexpr (!SECOND) {
        bf16_t* pw = O1 + lane_off; asm volatile("" : "+v"(pw));
#pragma unroll
        for (int r = 0; r < 16; ++r) {
#pragma unroll
            for (int d0 = 0; d0 < 4; ++d0) pw[d0 * 32] = (bf16_t)(cvt_pk_bf16(o[d0][r] * rli[r], 0.f) & 0xffffu);
            ROWWALK(pw, r); }
    } else {
        float sw[4];
#pragma unroll
        for (int d0 = 0; d0 < 4; ++d0) sw[d0] = subln[d0 * 32 + r32] * 0.8f;
        const bf16_t* pr = O1 + lane_off; asm volatile("" : "+v"(pr));
        float ssr[16];
#pragma unroll
        for (int r = 0; r < 16; ++r) { float sq = 0.f;
#pragma unroll
            for (int d0 = 0; d0 < 4; ++d0) { const float o1v = __uint_as_float(((unsigned)pr[d0 * 32]) << 16);
                const float y = o1v - lam * (o[d0][r] * rli[r]); o[d0][r] = y; sq += y * y; }
            ssr[r] = sq; ROWWALK(pr, r); }
#pragma unroll
        for (int m = 1; m < 32; m <<= 1)
#pragma unroll
            for (int r = 0; r < 16; ++r) ssr[r] += __shfl_xor(ssr[r], m);
        bf16_t* pw = Hd + lane_off; asm volatile("" : "+v"(pw));
#pragma unroll
        for (int r = 0; r < 16; ++r) { const float rstd = rsqrtf(ssr[r] * (1.f / 128.f) + EPS);
#pragma unroll
            for (int d0 = 0; d0 < 4; ++d0) pw[d0 * 32] = (bf16_t)(cvt_pk_bf16(o[d0][r] * rstd * sw[d0], 0.f) & 0xffffu);
            ROWWALK(pw, r); }
    }
#undef ROWWALK
    WAIT_BAR(0);
#undef DMA
#undef WAIT_BAR
}
#undef SBAR
}

struct Args { const float* in[23]; float* out; unsigned char* ws; int lo, hi; };
enum { I_X = 0, I_C, I_CTX, I_CCTX, I_WMOD, I_BMOD, I_NAW, I_WIN, I_QNW, I_KNW, I_LQ1, I_LK1, I_LQ2, I_LK2, I_SUBLN, I_POOLW, I_POOLS, I_WA, I_WB, I_WO, I_NMW, I_FF1, I_FF2 };
constexpr int LDS_BYTES = 131072 + 1024;

__device__ __forceinline__ void p0_transpose_item(const float* W, int K, int N, bf16_t* WT, LAS float* scr, int item, int lane) {
    const int nblk = N / 32, kb = item / nblk, nb = item % nblk, k0 = 64 * kb, n0 = 32 * nb;
#pragma unroll 8
    for (int i = 0; i < 32; ++i) { const int kk = 2 * i + (lane >> 5); scr[kk * 33 + (lane & 31)] = W[(size_t)(k0 + kk) * N + n0 + (lane & 31)]; }
    asm volatile("s_waitcnt lgkmcnt(0)" ::: "memory");
    const int c = lane & 7;
#pragma unroll
    for (int j = 0; j < 4; ++j) { const int n = (lane >> 3) + 8 * j; const LAS float* s = scr + (8 * c) * 33 + n;
        u32x4 o; o.x = cvt_pk_bf16(s[0 * 33], s[1 * 33]); o.y = cvt_pk_bf16(s[2 * 33], s[3 * 33]); o.z = cvt_pk_bf16(s[4 * 33], s[5 * 33]); o.w = cvt_pk_bf16(s[6 * 33], s[7 * 33]);
        *(u32x4*)(WT + (size_t)(n0 + n) * K + k0 + 8 * c) = o; }
    asm volatile("s_waitcnt lgkmcnt(0)" ::: "memory");
}

template <typename XT>
__device__ __forceinline__ void modulate_rows(const XT* X, int nrows, int rpw, const float* nw, const float* mod, int shift_off, int scale_off, int rows_per_batch, bf16_t* out, int gw, int NGW, int lane) {
    for (int m0 = gw * rpw; m0 < nrows; m0 += NGW * rpw) {
        const int r = rows_per_batch ? m0 / rows_per_batch : 4;
        const float* mr = mod + (size_t)r * NMOD;
        for (int mi = 0; mi < rpw; mi += 2) {
            const int m = m0 + mi;
            f32x4 v[2][8];
            if constexpr (sizeof(XT) == 4) {
#pragma unroll
                for (int q = 0; q < 2; ++q) { const f32x4* xr = (const f32x4*)((const float*)X + (size_t)(m + q) * DM) + lane;
#pragma unroll
                    for (int j = 0; j < 8; ++j) v[q][j] = __builtin_nontemporal_load(xr + 64 * j); }
            } else {
                u32x2 w[2][8];
#pragma unroll
                for (int q = 0; q < 2; ++q) { const u32x2* xr = (const u32x2*)((const bf16_t*)X + (size_t)(m + q) * DM) + lane;
#pragma unroll
                    for (int j = 0; j < 8; ++j) w[q][j] = xr[64 * j]; }
#pragma unroll
                for (int q = 0; q < 2; ++q)
#pragma unroll
                    for (int j = 0; j < 8; ++j) v[q][j] = (f32x4){bflo(w[q][j].x), bfhi(w[q][j].x), bflo(w[q][j].y), bfhi(w[q][j].y)};
            }
            float rstd[2];
#pragma unroll
            for (int q = 0; q < 2; ++q) { float ss = 0.f;
#pragma unroll
                for (int j = 0; j < 8; ++j) ss += (v[q][j].x * v[q][j].x + v[q][j].y * v[q][j].y) + (v[q][j].z * v[q][j].z + v[q][j].w * v[q][j].w);
                rstd[q] = rsqrtf(wave_sum(ss) * (1.f / DM) + EPS); }
#pragma unroll
            for (int j = 0; j < 8; ++j) { const int col = (lane + 64 * j) * 4;
                const f32x4 Ac = *(const f32x4*)(nw + col) * (*(const f32x4*)(mr + scale_off + col) + 1.0f), Bc = *(const f32x4*)(mr + shift_off + col);
#pragma unroll
                for (int q = 0; q < 2; ++q) { const f32x4 y = (v[q][j] * rstd[q]) * Ac + Bc;
                    u32x2 o; o.x = cvt_pk_bf16(y.x, y.y); o.y = cvt_pk_bf16(y.z, y.w);
                    *(u32x2*)(out + (size_t)(m + q) * DM + col) = o; } }
        }
    }
}

__device__ __forceinline__ void grid_bar(unsigned* ctr, unsigned k, int tid) {
    asm volatile("s_waitcnt vmcnt(0) lgkmcnt(0)" ::: "memory");
    __syncthreads();
    if (tid == 0) {
        __builtin_amdgcn_fence(__ATOMIC_RELEASE, "agent");
        asm volatile("s_waitcnt vmcnt(0)" ::: "memory");
        const unsigned G = gridDim.x, grp = blockIdx.x >> 5, ngrp = (G + 31u) >> 5, gsz = (grp + 1u) * 32u <= G ? 32u : G - grp * 32u;
        const unsigned old = __hip_atomic_fetch_add(ctr + 64 * (1 + grp), 1u, __ATOMIC_RELAXED, __HIP_MEMORY_SCOPE_AGENT);
        if (old + 1u == k * gsz) __hip_atomic_fetch_add(ctr, 1u, __ATOMIC_RELAXED, __HIP_MEMORY_SCOPE_AGENT);
        while (__hip_atomic_load(ctr, __ATOMIC_RELAXED, __HIP_MEMORY_SCOPE_AGENT) < k * ngrp) __builtin_amdgcn_s_sleep(1);
        __builtin_amdgcn_fence(__ATOMIC_ACQUIRE, "agent");
        asm volatile("s_waitcnt vmcnt(0)" ::: "memory");
    }
    __syncthreads();
}

__global__ void __launch_bounds__(512, 2) fwd_kernel(Args args) {
    extern __shared__ __attribute__((aligned(16))) unsigned char lds[];
    LAS unsigned char* ldsl = (LAS unsigned char*)lds;
    int wave_k = __builtin_amdgcn_readfirstlane((int)threadIdx.x >> 6); asm volatile("" : "+s"(wave_k));
    int lo, hi;
    { const Args __attribute__((address_space(4)))* A0 = (const Args __attribute__((address_space(4)))*)(unsigned long long)__builtin_amdgcn_kernarg_segment_ptr(); lo = A0->lo; hi = A0->hi; }
#define PH_VARS \
    const Args __attribute__((address_space(4)))* A_; { unsigned long long kp_ = (unsigned long long)__builtin_amdgcn_kernarg_segment_ptr(); asm volatile("" : "+s"(kp_)); A_ = (const Args __attribute__((address_space(4)))*)kp_; } \
    int tid = wave_k * 64 + lane_id_opaque(); asm volatile("" : "+v"(tid)); \
    const int lane = tid & 63, wave = __builtin_amdgcn_readfirstlane(tid >> 6); \
    const int G = gridDim.x, bx = blockIdx.x; \
    const int vcu = (G % 8 == 0) ? (bx % 8) * (G / 8) + bx / 8 : bx; \
    const int gw = vcu * 8 + wave, NGW = G * 8; \
    unsigned char* ws = A_->ws; \
    float* mod = (float*)(ws + WS_MOD); float* rope = (float*)(ws + WS_ROPE); \
    bf16_t* Win_t = (bf16_t*)(ws + WS_WIN); bf16_t* Wff1_t = (bf16_t*)(ws + WS_WFF1); bf16_t* Wff2_t = (bf16_t*)(ws + WS_WFF2); bf16_t* Wo_t = (bf16_t*)(ws + WS_WO); \
    bf16_t* Wa_t = (bf16_t*)(ws + WS_WA); bf16_t* Wb_t = (bf16_t*)(ws + WS_WB); bf16_t* Wp_t = (bf16_t*)(ws + WS_WP); \
    bf16_t* Hb = (bf16_t*)(ws + WS_H); bf16_t* HCb = (bf16_t*)(ws + WS_HC); bf16_t* QKV = (bf16_t*)(ws + WS_QKV); bf16_t* PG = (bf16_t*)(ws + WS_PG); \
    bf16_t* Db = (bf16_t*)(ws + WS_D); bf16_t* POOLED = (bf16_t*)(ws + WS_POOLED); bf16_t* OSUB = (bf16_t*)(ws + WS_OSUB); \
    bf16_t* HEADS = (bf16_t*)(ws + WS_HEADS); bf16_t* X1 = (bf16_t*)(ws + WS_X1); (void)X1; bf16_t* Mb = (bf16_t*)(ws + WS_M); bf16_t* H2 = (bf16_t*)(ws + WS_H2); bf16_t* Ub = (bf16_t*)(ws + WS_U); \
    (void)lane; (void)wave; (void)gw; (void)NGW; (void)mod; (void)rope; (void)Win_t; (void)Wff1_t; (void)Wff2_t; (void)Wo_t; (void)Wa_t; (void)Wb_t; (void)Wp_t; (void)Hb; (void)HCb; (void)QKV; (void)PG; \
    (void)Db; (void)POOLED; (void)OSUB; (void)HEADS; (void)Mb; (void)H2; (void)Ub; (void)bx; (void)vcu;
#ifndef PH_MASK
#define PH_MASK 0x3ff
#endif
#define IN(k) (((PH_MASK >> (k)) & 1) && lo <= (k) && (k) < hi)
#define SEAM(k) do { if (IN(k) && IN((k) + 1)) { if ((k) == 0) { cg::this_grid().sync(); } else { \
        const Args __attribute__((address_space(4)))* Ab_ = (const Args __attribute__((address_space(4)))*)(unsigned long long)__builtin_amdgcn_kernarg_segment_ptr(); \
        grid_bar((unsigned*)(Ab_->ws + WS_BAR), (unsigned)(k), wave_k * 64 + lane_id_opaque()); } } } while (0)

    if (IN(0)) { PH_VARS;
        {
            float* sc = (float*)lds;
            const float* c = A_->in[I_C]; const float* cc = A_->in[I_CCTX];
            for (int i = tid; i < 5 * DM; i += 512) { const int r = i / DM, k = i % DM; const float v = (r < 4) ? c[r * DM + k] : cc[k]; sc[i] = v / (1.0f + __expf(-v)); }
            __syncthreads();
            const float* wm = A_->in[I_WMOD]; const float* bm = A_->in[I_BMOD];
            float* red = (float*)(lds + 40960);
            for (int cb = bx; cb < NMOD / 48; cb += G) {
                const int col0 = cb * 48;
                if (tid < 504) {
                    const int cgp = tid % 12, ks = tid / 12;
                    float a[5][4];
#pragma unroll
                    for (int r = 0; r < 5; ++r)
#pragma unroll
                        for (int j = 0; j < 4; ++j) a[r][j] = 0.f;
                    for (int k = ks; k < DM; k += 42) {
                        const f32x4 w = *(const f32x4*)(wm + (size_t)k * NMOD + col0 + cgp * 4);
#pragma unroll
                        for (int r = 0; r < 5; ++r) { const float s = sc[r * DM + k]; a[r][0] += s * w.x; a[r][1] += s * w.y; a[r][2] += s * w.z; a[r][3] += s * w.w; }
                    }
#pragma unroll
                    for (int r = 0; r < 5; ++r)
#pragma unroll
                        for (int j = 0; j < 4; ++j) red[(r * 4 + j) * 504 + tid] = a[r][j];
                }
                __syncthreads();
                if (tid < 240) { const int r = tid / 48, ccol = tid % 48, cgp = ccol / 4, j = ccol % 4; float s = 0.f;
                    for (int ks = 0; ks < 42; ++ks) s += red[(r * 4 + j) * 504 + ks * 12 + cgp];
                    mod[r * NMOD + col0 + ccol] = s + bm[col0 + ccol]; }
                __syncthreads();
            }
            if (bx == 0 && tid <= 16) __hip_atomic_store((unsigned*)(ws + WS_BAR) + 64 * tid, 0u, __ATOMIC_RELAXED, __HIP_MEMORY_SCOPE_AGENT);
            if (bx == 0) for (int i = tid; i < 128 * 16; i += 512) { const int pos = i >> 4, f = i & 15;
                const float inv = powf(10000.0f, -(float)(2 * f) / 32.0f); float sn, cs; sincosf((float)pos * inv, &sn, &cs); rope[2 * i] = cs; rope[2 * i + 1] = sn; }
            __syncthreads();
        }
        LAS float* scr = (LAS float*)(ldsl + wave * 16384);
        constexpr int I_IN = (DM / 64) * (INW / 32), I_F1 = (DM / 64) * (DFF / 32), I_F2 = (DFF / 64) * (DM / 32), I_O = (DM / 64) * (DM / 32), I_A = (1024 / 64) * (DM / 32), I_P = 4 * 8;
        constexpr int NITEMS = I_IN + I_F1 + I_F2 + I_O + 2 * I_A + 4 * I_P;
        for (int it = gw; it < NITEMS; it += NGW) {
            int r = it;
            if (r < I_IN) { p0_transpose_item(A_->in[I_WIN], DM, INW, Win_t, scr, r, lane); continue; } r -= I_IN;
            if (r < I_F1) { p0_transpose_item(A_->in[I_FF1], DM, DFF, Wff1_t, scr, r, lane); continue; } r -= I_F1;
            if (r < I_F2) { p0_transpose_item(A_->in[I_FF2], DFF, DM, Wff2_t, scr, r, lane); continue; } r -= I_F2;
            if (r < I_O) { p0_transpose_item(A_->in[I_WO], DM, DM, Wo_t, scr, r, lane); continue; } r -= I_O;
            if (r < I_A) { p0_transpose_item(A_->in[I_WA], 1024, DM, Wa_t, scr, r, lane); continue; } r -= I_A;
            if (r < I_A) { p0_transpose_item(A_->in[I_WB], 1024, DM, Wb_t, scr, r, lane); continue; } r -= I_A;
            const int gq = r / I_P; r -= gq * I_P;
            p0_transpose_item(A_->in[I_POOLW] + (size_t)gq * 65536, 256, 256, Wp_t + (size_t)gq * 65536, scr, r, lane);
        }
    }
    SEAM(0);
    if (IN(1)) { PH_VARS;
        modulate_rows<float>(A_->in[I_X], MTOK, 16, A_->in[I_NAW], mod, 0, DM, SEQ, Hb, gw, NGW, lane);
        modulate_rows<float>(A_->in[I_CTX], NB * CTX, 4, A_->in[I_NAW], mod, 0, DM, 0, HCb, gw, NGW, lane);
    }
    SEAM(1);
    if (IN(2)) { PH_VARS;
        { pg8::Gemm g{Hb, Win_t, MTOK, INW, DM, DM, DM, 0, 128, 128}; pg8::StaticOrder S; S.init(MTOK, INW, G, bx);
          pg8::Epi<pg8::E_G1> E{QKV, PG, nullptr, nullptr, nullptr, nullptr};
          pg8::gemm_phase(tid, ldsl, g, S, E); }
        { pg8::Gemm g{HCb, Win_t + (size_t)1024 * DM, NB * CTX, 2048, DM, DM, DM, 0, 128, 128}; pg8::StaticOrder S; S.init(NB * CTX, 2048, G, bx);
          pg8::Epi<pg8::E_CTX> E{QKV, nullptr, nullptr, nullptr, nullptr, nullptr};
          pg8::gemm_phase(tid, ldsl, g, S, E); }
    }
    SEAM(2);
    if (IN(3)) { PH_VARS;
        const float* qnw = A_->in[I_QNW]; const float* knw = A_->in[I_KNW];
        for (int R = gw; R < MKV; R += NGW) {
            const int t = R % SKV; const bool isc = t >= SEQ;
            const int head = lane >> 1, half = lane & 1;
            bf16_t* p = QKV + (size_t)R * LDQKV + head * 64 + half * 32;
            float y[32];
            { u32x4 a = {0u, 0u, 0u, 0u}, b = a, c = a, d = a;
              if (head >= 16) { a = *(const u32x4*)p; b = *(const u32x4*)(p + 8); c = *(const u32x4*)(p + 16); d = *(const u32x4*)(p + 24); }
              const unsigned w[16] = {a.x, a.y, a.z, a.w, b.x, b.y, b.z, b.w, c.x, c.y, c.z, c.w, d.x, d.y, d.z, d.w};
#pragma unroll
              for (int i = 0; i < 16; ++i) { y[2 * i] = bflo(w[i]); y[2 * i + 1] = bfhi(w[i]); } }
            float ss = 0.f;
#pragma unroll
            for (int i = 0; i < 32; ++i) ss += y[i] * y[i];
            ss += __shfl_xor(ss, 1);
            const float rstd = rsqrtf(ss * (1.f / 64.f) + EPS);
            const float* nw = (head < 16 ? qnw : knw) + half * 32;
#pragma unroll
            for (int i = 0; i < 32; ++i) y[i] = y[i] * rstd * nw[i];
            if (!isc) {
                const int pos = half ? (t & 63) : (t >> 6);
                const float* tb = rope + pos * 32;
#pragma unroll
                for (int i = 0; i < 16; ++i) { const float cs = tb[2 * i], sn = tb[2 * i + 1], a = y[i], b = y[i + 16]; y[i] = a * cs - b * sn; y[i + 16] = a * sn + b * cs; }
            }
            if (head >= 16) {
                u32x4 o[4];
#pragma unroll
                for (int q = 0; q < 4; ++q) { o[q].x = cvt_pk_bf16(y[8 * q], y[8 * q + 1]); o[q].y = cvt_pk_bf16(y[8 * q + 2], y[8 * q + 3]); o[q].z = cvt_pk_bf16(y[8 * q + 4], y[8 * q + 5]); o[q].w = cvt_pk_bf16(y[8 * q + 6], y[8 * q + 7]); }
                *(u32x4*)p = o[0]; *(u32x4*)(p + 8) = o[1]; *(u32x4*)(p + 16) = o[2]; *(u32x4*)(p + 24) = o[3];
            }
        }
        for (long it = (long)vcu * 512 + tid; it < (long)MTOK * 128; it += (long)G * 512) {
            const int row = (int)(it >> 7), ch = (int)(it & 127), gq = ch >> 5, w = 2 << gq;
            const int t = row & (SEQ - 1), rb = row - t;
            const int l0 = max(t - w / 2, 0), h0 = min(t + w - w / 2, SEQ);
            float s[8];
#pragma unroll
            for (int i = 0; i < 8; ++i) s[i] = 0.f;
            for (int tt = l0; tt < h0; ++tt) { const u32x4 a = *(const u32x4*)(PG + (size_t)(rb + tt) * LDPG + ch * 8);
                s[0] += bflo(a.x); s[1] += bfhi(a.x); s[2] += bflo(a.y); s[3] += bfhi(a.y); s[4] += bflo(a.z); s[5] += bfhi(a.z); s[6] += bflo(a.w); s[7] += bfhi(a.w); }
            const float inv = 1.0f / (float)(h0 - l0);
            const u32x4 a = *(const u32x4*)(PG + (size_t)row * LDPG + ch * 8);
            u32x4 o; o.x = cvt_pk_bf16(s[0] * inv - bflo(a.x), s[1] * inv - bfhi(a.x)); o.y = cvt_pk_bf16(s[2] * inv - bflo(a.y), s[3] * inv - bfhi(a.y));
            o.z = cvt_pk_bf16(s[4] * inv - bflo(a.z), s[5] * inv - bfhi(a.z)); o.w = cvt_pk_bf16(s[6] * inv - bflo(a.w), s[7] * inv - bfhi(a.w));
            *(u32x4*)(Db + (size_t)row * 1024 + ch * 8) = o;
        }
    }
    SEAM(3);
    if (IN(4)) { PH_VARS;
        { pg8::Gemm g{Db, Wp_t, MTOK, 1024, 256, 1024, 256, 256, 128, 128}; pg8::StaticOrder S; S.init(MTOK, 1024, G, bx);
          pg8::Epi<pg8::E_POOL> E{POOLED, nullptr, nullptr, nullptr, A_->in[I_POOLS], nullptr};
          pg8::gemm_phase(tid, ldsl, g, S, E); }
        __syncthreads();
    }
    if (IN(4)) { PH_VARS;
        float KN; { float w = fabsf(A_->in[I_KNW][lane]);
#pragma unroll
            for (int o = 1; o < 64; o <<= 1) w = fmaxf(w, __shfl_xor(w, o));
            KN = 8.0f * w * 1.01f; }
        const float l1 = wave_sum(A_->in[I_LQ1][lane] * A_->in[I_LK1][lane]), l2 = wave_sum(A_->in[I_LQ2][lane] * A_->in[I_LK2][lane]);
        const float lam_init = 0.2f, lam = __expf(l1) - __expf(l2) + lam_init;
        const float* subln = A_->in[I_SUBLN];
        for (int U = vcu; U < NB * 8 * (SEQ / 256); U += G) {
            const int bh = U >> 5, qb = U & 31, b = bh >> 3, h = bh & 7;
            const bf16_t* base = QKV + (size_t)b * SKV * LDQKV;
            const bf16_t* qp = base + (size_t)qb * 256 * LDQKV + h * 128; const bf16_t* kp = base + 1024 + h * 128; const bf16_t* vp = base + 2048 + h * 128;
            bf16_t* o1 = OSUB + (size_t)(b * SEQ + qb * 256) * 1024 + h * 128; bf16_t* hd = HEADS + (size_t)(b * SEQ + qb * 256) * 1024 + h * 128;
            att::attn_unit<false>(qp, kp, vp, o1, hd, lam, subln, SKV, KN, (char*)lds, ldsl, wave_k, A_->in[I_QNW], rope, qb * 256);
            att::attn_unit<true>(qp + 64, kp + 64, vp, o1, hd, lam, subln, SKV, KN, (char*)lds, ldsl, wave_k, A_->in[I_QNW], rope, qb * 256);
        }
    }
    SEAM(4);
    if (IN(5)) { PH_VARS;
        pg8::Gemm g{HEADS, Wa_t, MTOK, DM, 1024, 1024, 1024, 0, 128, 128, POOLED, Wb_t}; pg8::PairOrder S; S.S.init(MTOK, DM, G, bx);
        pg8::Epi<pg8::E_YAB> E{Mb, nullptr, nullptr, nullptr, nullptr, PG};
        pg8::gemm_phase(tid, ldsl, g, S, E);
    }
    SEAM(5);
    if (IN(6)) { PH_VARS;
        pg8::Gemm g{Mb, Wo_t, MTOK, DM, DM, DM, DM, 0, 128, 128}; pg8::StaticOrder S; S.init(MTOK, DM, G, bx);
        pg8::Epi<pg8::E_WO> E{X1, nullptr, nullptr, A_->in[I_X], mod + 2 * DM, nullptr};
        pg8::gemm_phase(tid, ldsl, g, S, E);
    }
    SEAM(6);
    if (IN(7)) { PH_VARS; modulate_rows<bf16_t>(X1, MTOK, 16, A_->in[I_NMW], mod, 3 * DM, 4 * DM, SEQ, H2, gw, NGW, lane); }
    SEAM(7);
    if (IN(8)) { PH_VARS;
        pg8::Gemm g{H2, Wff1_t, MTOK, DFF, DM, DM, DM, 0, 128, 128}; pg8::StaticOrder S; S.init(MTOK, DFF, G, bx);
        pg8::Epi<pg8::E_FF1> E{Ub, nullptr, nullptr, nullptr, nullptr, nullptr};
        pg8::gemm_phase(tid, ldsl, g, S, E);
    }
    SEAM(8);
    if (IN(9)) { PH_VARS;
        pg8::Gemm g{Ub, Wff2_t, MTOK, DM, DFF, 64, DFF, 0, (size_t)MTOK * 128, 128};   pg8::StaticOrder S; S.init(MTOK, DM, G, bx);
        pg8::Epi<pg8::E_FF2> E{nullptr, nullptr, A_->out, nullptr, mod + 5 * DM, X1};
        pg8::gemm_phase(tid, ldsl, g, S, E);
    }
#undef IN
#undef SEAM
}

extern "C" void kernel_launch(void* const* d_in, const int* in_sizes, int n_in, void* d_out, int out_size, void* d_ws, size_t ws_size, hipStream_t stream) {
    static int grid = 0;
    if (grid == 0) {
        if (n_in != 23 || in_sizes[0] != MTOK * DM || out_size != MTOK * DM || ws_size < WS_END) {
            fprintf(stderr, "kernel_launch: shape mismatch n_in %d in0 %d out %d ws %zu (need %zu)\n", n_in, n_in > 0 ? in_sizes[0] : -1, out_size, ws_size, (size_t)WS_END); grid = -1; return; }
        int dev = 0, cus = 0, per_cu = 0;
        hipGetDevice(&dev); hipDeviceGetAttribute(&cus, hipDeviceAttributeMultiprocessorCount, dev);
        if (hipFuncSetAttribute((const void*)fwd_kernel, hipFuncAttributeMaxDynamicSharedMemorySize, LDS_BYTES) != hipSuccess) { fprintf(stderr, "kernel_launch: hipFuncSetAttribute failed\n"); grid = -1; return; }
        hipOccupancyMaxActiveBlocksPerMultiprocessor(&per_cu, (const void*)fwd_kernel, 512, LDS_BYTES);
        if (per_cu < 1) { fprintf(stderr, "kernel_launch: occupancy query says %d blocks/CU\n", per_cu); per_cu = 1; }
        (void)hipGetLastError();
        grid = cus;
    }
    if (grid < 0) return;
#if MK_MULTI
    if (hipMemsetAsync((char*)d_ws + WS_BAR, 0, 256, stream) != hipSuccess) { fprintf(stderr, "kernel_launch: memset failed\n"); return; }
#endif
    Args a{};
    for (int i = 0; i < 23; ++i) a.in[i] = (const float*)d_in[i];
    a.out = (float*)d_out; a.ws = (unsigned char*)d_ws;
#if MK_MULTI
    for (int p = 0; p < NPHASE; ++p) for (int rep = 0; rep < 1 + ((MK_REP_MASK >> p) & 1); ++rep) { a.lo = p; a.hi = p + 1; hipLaunchKernelGGL(fwd_kernel, dim3(grid), dim3(512), LDS_BYTES, stream, a); }
#else
    a.lo = 0; a.hi = NPHASE;
    void* kargs[] = {&a};
    hipError_t e = hipLaunchCooperativeKernel((const void*)fwd_kernel, dim3(grid), dim3(512), kargs, LDS_BYTES, stream);
    if (e != hipSuccess) fprintf(stderr, "cooperative launch failed: %s (grid %d)\n", hipGetErrorString(e), grid);
#endif
}
```
